# Optimizing an MI355X kernel written in HIP

```python
import jax
import jax.numpy as jnp
from jax import lax
import numpy as np

D_MODEL = 1024
BATCH = 8
SEQ = 4096
DEPTH = 4

GRID_W = 64
CTX_LEN = 256
N_EVEN = (DEPTH + 1) // 2
N_ODD = DEPTH // 2
D_FF = 4 * D_MODEL
N_MOD = 6
EPS = 1e-6

ML_DK = 128
ML_DV = 128
ML_HEADS = D_MODEL // (2 * ML_DV)
ML_QK = ML_HEADS * ML_DK
ML_W = ML_HEADS * ML_DV
ML_CHUNK = 128
GATE_CAP = 15.0

AT_DH = 64
AT_HEADS = D_MODEL // (2 * AT_DH)
AT_KV_HEADS = AT_HEADS // 4
AT_GROUP = AT_HEADS // AT_KV_HEADS
AT_W = AT_HEADS * AT_DH
AT_KV_W = AT_KV_HEADS * AT_DH
WINDOW = 128
AT_BLOCK = 128
ROPE_BASE = 10000.0

EV_SIZES = (ML_QK, ML_QK, ML_W, ML_W, 4 * ML_HEADS, AT_W, AT_KV_W, AT_KV_W)
P_EVEN = 2 * ML_QK + 2 * ML_W + 4 * ML_HEADS + AT_W + 2 * AT_KV_W
MIX_W = ML_W + AT_W

RW_HEAD = 64
RW_HEADS = D_MODEL // RW_HEAD
RW_DECAY_LORA = 64
RW_AAA_LORA = 64
RW_GATE_LORA = 160
RW_LN_EPS = 64e-5

kernel_name = 'hybrid_mlstm_swa_rwkv7_dit_trunk'


def split_points():
    pts, acc = [], 0
    for s in EV_SIZES[:-1]:
        acc += s
        pts.append(acc)
    return pts


def rmsnorm(u, g):
    uf = u.astype(jnp.float32)
    y = uf * lax.rsqrt(jnp.mean(uf * uf, axis=-1, keepdims=True) + EPS)
    return (y * g.astype(jnp.float32)).astype(u.dtype)


def softcap(u):
    return GATE_CAP * jnp.tanh(u / GATE_CAP)


def modulate(u, lc, shift_c, scale_c, shift_l, scale_l):
    uc = u[:, :lc] * (1 + scale_c) + shift_c
    ul = u[:, lc:] * (1 + scale_l[:, None]) + shift_l[:, None]
    return jnp.concatenate([uc, ul], axis=1)


def apply_gate(y, lc, gate_c, gate_l):
    return jnp.concatenate([y[:, :lc] * gate_c, y[:, lc:] * gate_l[:, None]], axis=1)


def dir_order(u, lc):
    return jnp.concatenate([jnp.flip(u[:, :lc], axis=1), jnp.flip(u[:, lc:], axis=1)], axis=1)


def seq_order(u, lc, d):
    return u if d == 0 else dir_order(u, lc)


def seg_shift(u, lc, step):
    t = u.shape[1]
    pos = jnp.arange(t)
    if step == 1:
        s = jnp.pad(u, ((0, 0), (1, 0), (0, 0)))[:, :-1]
        border = (pos == 0) | (pos == lc)
    else:
        s = jnp.pad(u, ((0, 0), (0, 1), (0, 0)))[:, 1:]
        border = (pos == lc - 1) | (pos == t - 1)
    return jnp.where(border[None, :, None], jnp.zeros((), u.dtype), s)


def axial_rope(u, rows):
    f32 = jnp.float32
    half = AT_DH // 2
    quarter = half // 2
    inv = ROPE_BASE ** (-jnp.arange(quarter, dtype=f32) / quarter)
    rpos = jnp.repeat(jnp.arange(rows, dtype=f32), GRID_W)
    cpos = jnp.tile(jnp.arange(GRID_W, dtype=f32), rows)

    def rot(xh, pos):
        ang = pos[:, None] * inv[None, :]
        cos = jnp.cos(ang)[None, :, None, :].astype(xh.dtype)
        sin = jnp.sin(ang)[None, :, None, :].astype(xh.dtype)
        x1, x2 = xh[..., :quarter], xh[..., quarter:]
        return jnp.concatenate([x1 * cos - x2 * sin, x1 * sin + x2 * cos], axis=-1)

    return jnp.concatenate([rot(u[..., :half], rpos), rot(u[..., half:], cpos)], axis=-1)


def band_blocks(u):
    b, s = u.shape[0], u.shape[1]
    nb = s // AT_BLOCK
    up = jnp.pad(u, ((0, 0), (AT_BLOCK, AT_BLOCK), (0, 0), (0, 0)))
    up = up.reshape(b, nb + 2, AT_BLOCK, AT_KV_HEADS, AT_DH)
    return jnp.concatenate([up[:, :-2], up[:, 1:-1], up[:, 2:]], axis=2)


def window_attention(q, k, v, lc, rows, q_g, k_g, sink):
    f32 = jnp.float32
    q = rmsnorm(q, q_g)
    k = rmsnorm(k, k_g)
    qc, kc, vc = q[:, :lc], k[:, :lc], v[:, :lc]
    ql = axial_rope(q[:, lc:], rows)
    kl = axial_rope(k[:, lc:], rows)
    vl = v[:, lc:]
    b, s = ql.shape[0], ql.shape[1]
    nb = s // AT_BLOCK
    nk = 3 * AT_BLOCK
    scale = AT_DH ** -0.5
    sink_hg = sink.astype(f32).reshape(1, 1, AT_KV_HEADS, AT_GROUP, 1, 1)
    qlb = ql.reshape(b, nb, AT_BLOCK, AT_KV_HEADS, AT_GROUP, AT_DH)
    kb, vb = band_blocks(kl), band_blocks(vl)
    s_band = jnp.einsum('bnqhgd,bnkhd->bnhgqk', qlb, kb).astype(f32) * scale
    s_ctx = jnp.einsum('bnqhgd,bkhd->bnhgqk', qlb, kc).astype(f32) * scale
    qi = jnp.arange(AT_BLOCK)[:, None]
    ki = jnp.arange(nk)[None, :]
    in_window = jnp.abs(ki - AT_BLOCK - qi) <= WINDOW
    kpos = (jnp.arange(nb)[:, None] - 1) * AT_BLOCK + jnp.arange(nk)[None, :]
    in_range = (kpos >= 0) & (kpos < s)
    valid = in_window[None] & in_range[:, None, :]
    s_band = jnp.where(valid[None, :, None, None], s_band, -jnp.inf)
    sink_l = jnp.broadcast_to(sink_hg, s_band.shape[:-1] + (1,))
    p = jax.nn.softmax(jnp.concatenate([s_band, s_ctx, sink_l], axis=-1), axis=-1)
    ol = (jnp.einsum('bnhgqk,bnkhd->bnqhgd', p[..., :nk].astype(v.dtype), vb)
          + jnp.einsum('bnhgqk,bkhd->bnqhgd', p[..., nk:nk + lc].astype(v.dtype), vc))
    ol = ol.reshape(b, s, AT_W)
    qcg = qc.reshape(b, lc, AT_KV_HEADS, AT_GROUP, AT_DH)
    s_cc = jnp.einsum('bqhgd,bkhd->bhgqk', qcg, kc).astype(f32) * scale
    sink_c = jnp.broadcast_to(sink_hg[0], s_cc.shape[:-1] + (1,))
    pc = jax.nn.softmax(jnp.concatenate([s_cc, sink_c], axis=-1), axis=-1)[..., :lc]
    oc = jnp.einsum('bhgqk,bkhd->bqhgd', pc.astype(v.dtype), vc).reshape(b, lc, AT_W)
    return jnp.concatenate([oc, ol], axis=1)


def mlstm_chunk_scan(q, k, v, ig, lf):
    b, h, t, dk = q.shape
    dv = v.shape[-1]
    L = ML_CHUNK
    nc = t // L

    def chunks(u):
        return jnp.moveaxis(u.reshape(u.shape[:2] + (nc, L) + u.shape[3:]), 2, 0)

    lower = jnp.tril(jnp.ones((L, L), dtype=bool))

    def step(carry, xs):
        C, n, m = carry
        qc, kc, vc, ic, fc = xs
        bcum = jnp.cumsum(fc, axis=-1)
        dlog = bcum[..., :, None] - bcum[..., None, :] + ic[..., None, :]
        dlog = jnp.where(lower, dlog, -jnp.inf)
        inter = bcum + m[..., None]
        mt = jnp.maximum(jnp.max(dlog, axis=-1), inter)
        dw = jnp.exp(dlog - mt[..., None])
        iw = jnp.exp(inter - mt)
        sc = jnp.einsum('bhtk,bhsk->bhts', qc, kc) * dw
        num = (jnp.einsum('bhts,bhsv->bhtv', sc, vc)
               + iw[..., None] * jnp.einsum('bhvk,bhtk->bhtv', C, qc))
        den = jnp.maximum(jnp.abs(jnp.sum(sc, axis=-1) + iw * jnp.einsum('bhk,bhtk->bht', n, qc)),
                          jnp.exp(-mt))
        hout = num / den[..., None]
        bl = bcum[..., -1]
        ws_log = bl[..., None] - bcum + ic
        m_new = jnp.maximum(bl + m, jnp.max(ws_log, axis=-1))
        ws = jnp.exp(ws_log - m_new[..., None])
        carry_decay = jnp.exp(bl + m - m_new)
        C = carry_decay[..., None, None] * C + jnp.einsum('bhsv,bhsk->bhvk', vc * ws[..., None], kc)
        n = carry_decay[..., None] * n + jnp.einsum('bhs,bhsk->bhk', ws, kc)
        return (C, n, m_new), hout

    f32 = jnp.float32
    init = (jnp.zeros((b, h, dv, dk), f32), jnp.zeros((b, h, dk), f32), jnp.zeros((b, h), f32))
    _, hs = lax.scan(step, init, (chunks(q), chunks(k), chunks(v), chunks(ig), chunks(lf)))
    return jnp.moveaxis(hs, 0, 2).reshape(b, h, t, dv)


def mlstm_mixer(q, k, v, o, gates, lc, f_bias, out_g):
    f32 = jnp.float32
    b, t, _ = q.shape
    qh = q.reshape(b, t, ML_HEADS, ML_DK).astype(f32)
    kh = k.reshape(b, t, ML_HEADS, ML_DK).astype(f32) * (ML_DK ** -0.5)
    vh = v.reshape(b, t, ML_HEADS, ML_DV).astype(f32)
    g = gates.reshape(b, t, 2, 2, ML_HEADS).astype(f32)
    ig = softcap(g[:, :, :, 0])
    lf = jax.nn.log_sigmoid(softcap(g[:, :, :, 1] + f_bias.astype(f32)))
    outs = []
    for d in range(2):
        def bhtd(u):
            return jnp.moveaxis(seq_order(u, lc, d), 2, 1)
        hd = mlstm_chunk_scan(bhtd(qh), bhtd(kh), bhtd(vh), bhtd(ig[:, :, d]), bhtd(lf[:, :, d]))
        outs.append(seq_order(jnp.moveaxis(hd, 1, 2), lc, d))
    hsum = rmsnorm(outs[0] + outs[1], out_g.reshape(ML_HEADS, ML_DV))
    return (hsum.reshape(b, t, ML_W) * jax.nn.sigmoid(o.astype(f32))).astype(q.dtype)


def even_mixer(h, lc, rows, w_in, b_in, w_out, f_bias, out_g, q_g, k_g, sink):
    b, t, _ = h.shape
    p = h @ w_in + b_in
    mq, mk, mv, mo, mg, aq, ak, av = jnp.split(p, split_points(), axis=-1)
    ym = mlstm_mixer(mq, mk, mv, mo, mg, lc, f_bias, out_g)
    ya = window_attention(aq.reshape(b, t, AT_HEADS, AT_DH), ak.reshape(b, t, AT_KV_HEADS, AT_DH),
                          av.reshape(b, t, AT_KV_HEADS, AT_DH), lc, rows, q_g, k_g, sink)
    return jnp.concatenate([ym, ya], axis=-1) @ w_out


def rwkv7_scan(r, w, k, v, a, bb):
    b, t, h, n = r.shape

    def step(S, xs):
        rt, wt, kt, vt, at, bt = xs
        S = (S * wt[:, :, None, :]
             + jnp.einsum('bhvk,bhk->bhv', S, at)[..., None] * bt[:, :, None, :]
             + vt[..., None] * kt[:, :, None, :])
        return S, jnp.einsum('bhvk,bhk->bhv', S, rt)

    xs = tuple(jnp.moveaxis(u, 1, 0) for u in (r, w, k, v, a, bb))
    _, y = lax.scan(step, jnp.zeros((b, h, n, n), jnp.float32), xs)
    return jnp.moveaxis(y, 0, 1)


def rwkv7_mixer(u, lc, mu, w_rkv, w0, w1, w2, a0, a1, a2, g1, g2, k_k, k_a, r_k, ln_g, ln_b, w_out):
    f32 = jnp.float32
    b, t, d_model = u.shape
    d_prev = seg_shift(u, lc, 1) - u
    d_next = seg_shift(u, lc, -1) - u
    xr, xw, xk, xv, xa, xg = [u + mu[i, 0] * d_prev + mu[i, 1] * d_next for i in range(6)]
    r = xr @ w_rkv[0]
    k = xk @ w_rkv[1]
    v = xv @ w_rkv[2]
    gate = jax.nn.sigmoid(xg @ g1) @ g2

    def heads(z):
        return z.reshape(b, t, RW_HEADS, RW_HEAD).astype(f32)

    kk = heads(k * k_k)
    kk = kk * lax.rsqrt(jnp.maximum(jnp.sum(kk * kk, axis=-1, keepdims=True), 1e-24))
    rh, vh = heads(r), heads(v)
    outs, bonus = [], []
    for d in range(2):
        w_log = -jax.nn.softplus(-(w0[d] + jnp.tanh(xw @ w1[d]) @ w2[d])) - 0.5
        decay = jnp.exp(-jnp.exp(heads(w_log)))
        a = jax.nn.sigmoid(a0[d] + (xa @ a1[d]) @ a2[d])
        kd = heads(k * (1 + (a - 1) * k_a))
        args = [seq_order(z, lc, d) for z in (rh, decay, kd, vh, -kk, kk * heads(a))]
        outs.append(seq_order(rwkv7_scan(*args), lc, d))
        bonus.append(jnp.sum(rh * kd * r_k.astype(f32), axis=-1, keepdims=True) * vh)
    y = outs[0] + outs[1]
    mean = jnp.mean(y, axis=-1, keepdims=True)
    var = jnp.mean(jnp.square(y - mean), axis=-1, keepdims=True)
    y = ((y - mean) * lax.rsqrt(var + RW_LN_EPS)).reshape(b, t, d_model)
    y = y * ln_g.astype(f32) + ln_b.astype(f32) + (bonus[0] + bonus[1]).reshape(b, t, d_model)
    return (y * gate.astype(f32)).astype(u.dtype) @ w_out


def channel_mixer(h, w1, w2):
    return jnp.square(jax.nn.relu(h @ w1)) @ w2


def setup_inputs(seed: int = 0) -> dict:
    key = jax.random.key(seed)
    ks = iter(jax.random.split(key, 48))
    f32 = jnp.float32
    D = D_MODEL

    def nrm(shape, scale):
        return jax.random.normal(next(ks), shape, f32) * scale

    return {
        'x': nrm((BATCH, SEQ, D), 1.0),
        'c': nrm((BATCH, D), 1.0),
        'ctx': nrm((BATCH, CTX_LEN, D), 1.0),
        'c_ctx': nrm((D,), 1.0),
        'ada_w': nrm((DEPTH, D, N_MOD * D), 0.5 * D ** -0.5),
        'ada_b': nrm((DEPTH, N_MOD * D), 0.02),
        'norm1_g': 1.0 + nrm((DEPTH, D), 0.02),
        'norm2_g': 1.0 + nrm((DEPTH, D), 0.02),
        'mlp_w1': nrm((DEPTH, D, D_FF), D ** -0.5),
        'mlp_w2': nrm((DEPTH, D_FF, D), D_FF ** -0.5),
        'ev_w_in': nrm((N_EVEN, D, P_EVEN), D ** -0.5),
        'ev_b_in': nrm((N_EVEN, P_EVEN), 0.02),
        'ev_w_out': nrm((N_EVEN, MIX_W, D), MIX_W ** -0.5),
        'ml_f_bias': jnp.linspace(3.0, 6.0, ML_HEADS, dtype=f32)[None, None] + nrm((N_EVEN, 2, ML_HEADS), 0.1),
        'ml_out_g': 1.0 + nrm((N_EVEN, ML_W), 0.02),
        'at_q_g': 1.0 + nrm((N_EVEN, AT_DH), 0.02),
        'at_k_g': 1.0 + nrm((N_EVEN, AT_DH), 0.02),
        'at_sink': nrm((N_EVEN, AT_HEADS), 0.5),
        'rw_mu': jax.random.uniform(next(ks), (N_ODD, 6, 2, D), f32, 0.0, 0.5),
        'rw_w_rkv': nrm((N_ODD, 3, D, D), D ** -0.5),
        'rw_w0': jnp.linspace(-6.0, -1.0, D, dtype=f32) + nrm((N_ODD, 2, D), 0.1),
        'rw_w1': nrm((N_ODD, 2, D, RW_DECAY_LORA), D ** -0.5),
        'rw_w2': nrm((N_ODD, 2, RW_DECAY_LORA, D), 0.1 * RW_DECAY_LORA ** -0.5),
        'rw_a0': nrm((N_ODD, 2, D), 0.1),
        'rw_a1': nrm((N_ODD, 2, D, RW_AAA_LORA), D ** -0.5),
        'rw_a2': nrm((N_ODD, 2, RW_AAA_LORA, D), 0.5 * RW_AAA_LORA ** -0.5),
        'rw_g1': nrm((N_ODD, D, RW_GATE_LORA), D ** -0.5),
        'rw_g2': nrm((N_ODD, RW_GATE_LORA, D), RW_GATE_LORA ** -0.5),
        'rw_k_k': 0.85 + nrm((N_ODD, D), 0.02),
        'rw_k_a': 1.0 + nrm((N_ODD, D), 0.02),
        'rw_r_k': nrm((N_ODD, RW_HEADS, RW_HEAD), 0.1),
        'rw_ln_g': 1.0 + nrm((N_ODD, D), 0.02),
        'rw_ln_b': nrm((N_ODD, D), 0.02),
        'rw_w_out': nrm((N_ODD, D, D), D ** -0.5),
    }


def reference(x, c, ctx, c_ctx, ada_w, ada_b, norm1_g, norm2_g, mlp_w1, mlp_w2,
              ev_w_in, ev_b_in, ev_w_out, ml_f_bias, ml_out_g, at_q_g, at_k_g, at_sink,
              rw_mu, rw_w_rkv, rw_w0, rw_w1, rw_w2, rw_a0, rw_a1, rw_a2, rw_g1, rw_g2,
              rw_k_k, rw_k_a, rw_r_k, rw_ln_g, rw_ln_b, rw_w_out):
    b, s, d_model = x.shape
    lc = ctx.shape[1]
    rows = s // GRID_W
    z = jnp.concatenate([ctx, x], axis=1)
    s_lat = jax.nn.silu(c)
    s_ctx = jax.nn.silu(c_ctx)
    for layer in range(DEPTH):
        mod_l = (s_lat @ ada_w[layer] + ada_b[layer]).reshape(b, N_MOD, d_model)
        mod_c = (s_ctx @ ada_w[layer] + ada_b[layer]).reshape(N_MOD, d_model)
        h = modulate(rmsnorm(z, norm1_g[layer]), lc, mod_c[0], mod_c[1], mod_l[:, 0], mod_l[:, 1])
        j = layer // 2
        if layer % 2 == 0:
            y = even_mixer(h, lc, rows, ev_w_in[j], ev_b_in[j], ev_w_out[j], ml_f_bias[j], ml_out_g[j],
                           at_q_g[j], at_k_g[j], at_sink[j])
        else:
            y = rwkv7_mixer(h, lc, rw_mu[j], rw_w_rkv[j], rw_w0[j], rw_w1[j], rw_w2[j], rw_a0[j],
                            rw_a1[j], rw_a2[j], rw_g1[j], rw_g2[j], rw_k_k[j], rw_k_a[j], rw_r_k[j],
                            rw_ln_g[j], rw_ln_b[j], rw_w_out[j])
        z = z + apply_gate(y, lc, mod_c[2], mod_l[:, 2])
        if layer == DEPTH - 1:
            z = z[:, lc:]
            lc = 0
        h = modulate(rmsnorm(z, norm2_g[layer]), lc, mod_c[3], mod_c[4], mod_l[:, 3], mod_l[:, 4])
        z = z + apply_gate(channel_mixer(h, mlp_w1[layer], mlp_w2[layer]), lc, mod_c[5], mod_l[:, 5])
    return z
```

```cpp
#include <hip/hip_runtime.h>
#include <hip/hip_cooperative_groups.h>
#include <cstdint>
#include <cstdio>
namespace cg = cooperative_groups;

#define LAS __attribute__((address_space(3)))
#define DI __device__ __forceinline__
typedef unsigned short bf16_t;
typedef short bf16x8 __attribute__((ext_vector_type(8)));
typedef float f32x4 __attribute__((ext_vector_type(4)));
typedef unsigned u32x4 __attribute__((ext_vector_type(4)));
typedef unsigned u32x2 __attribute__((ext_vector_type(2)));
typedef float f32x2 __attribute__((ext_vector_type(2)));

constexpr int NB = 8, LC = 256, SL = 4096, T = LC + SL, D = 1024, M = NB * T, FF = 4096;
constexpr int PW = 2816;
constexpr int QROWS = 2 * T;
constexpr int NTHREADS = 512;
constexpr int LDS_BYTES = 155648;
#ifndef PH
#define PH 0x7fff
#endif

constexpr size_t MiB = 1u << 20;
constexpr size_t WS_ZC = 0;
constexpr size_t WS_MOD = 8 * MiB;
constexpr size_t WS_TAB = 9 * MiB;
constexpr size_t WS_W = 10 * MiB;
constexpr size_t W_IN_T = WS_W;
constexpr size_t W_EVO_T = W_IN_T + 12 * MiB;
constexpr size_t W_M1_T = W_EVO_T + 4 * MiB;
constexpr size_t W_M2_T = W_M1_T + 32 * MiB;
constexpr size_t W_RKVL_T = W_M2_T + 32 * MiB;
constexpr size_t W_RWO_T = W_RKVL_T + 15 * MiB;
constexpr size_t W_2W_T = W_RWO_T + 4 * MiB;
constexpr size_t W_2A_T = W_2W_T + MiB / 2;
constexpr size_t W_G2_T = W_2A_T + MiB / 2;
constexpr size_t RA = 112 * MiB;
constexpr size_t EV_H = RA;
constexpr size_t EV_P = RA + 68 * MiB;
constexpr size_t EV_G = RA + 255 * MiB;
constexpr size_t EV_HB = RA + 258 * MiB;
constexpr size_t ML_H = RA;
constexpr size_t ML_HID = RA + 68 * MiB;
constexpr size_t OD_XQ = RA;
constexpr size_t OD_Y = RA;
constexpr size_t OD_RKV = RA + 136 * MiB;
constexpr size_t OD_L1 = RA + 340 * MiB;
constexpr size_t OD_G1 = RA + 357 * MiB;
constexpr size_t OD_SB = RA + 374 * MiB;
constexpr size_t WS_NEED = RA + 380 * MiB;

struct Params { const float* in[34]; float* out; unsigned char* ws; };
#define CAS __attribute__((address_space(4)))
__device__ __forceinline__ const void* kload(int off) {
    const CAS char* base = (const CAS char*)__builtin_amdgcn_kernarg_segment_ptr();
    asm volatile("" : "+s"(base));
    return *(const void* const CAS*)(base + off);
}
#define IN(k) ((const float*)kload(8 * (k)))
#define OUTP() ((float*)kload(272))
#define WSP() ((unsigned char*)kload(280))

DI unsigned f2bf(float f) { unsigned u = __builtin_bit_cast(unsigned, f); return (u + 0x7fffu + ((u >> 16) & 1u)) >> 16; }
DI unsigned pk2(float lo, float hi) { return f2bf(lo) | (f2bf(hi) << 16); }
DI float bflo(unsigned u) { return __builtin_bit_cast(float, u << 16); }
DI float bfhi(unsigned u) { return __builtin_bit_cast(float, u & 0xffff0000u); }
DI float bf1(bf16_t h) { return __builtin_bit_cast(float, ((unsigned)h) << 16); }
DI float sigmoidf_(float x) { return 1.f / (1.f + __expf(-x)); }
DI float tanhf_(float x) { float e = __expf(2.f * x); return 1.f - 2.f / (e + 1.f); }
DI float softcap_(float u) { return 15.f * tanhf_(u * (1.f / 15.f)); }
template <int CTRL> DI float dppmov(float x) { return __builtin_bit_cast(float, __builtin_amdgcn_update_dpp(0, __builtin_bit_cast(int, x), CTRL, 0xf, 0xf, true)); }
DI float red16(float x) { x += dppmov<0xB1>(x); x += dppmov<0x4E>(x); x += dppmov<0x141>(x); x += dppmov<0x140>(x); return x; }
DI float red8(float x) { x += dppmov<0xB1>(x); x += dppmov<0x4E>(x); x += dppmov<0x141>(x); return x; }
DI float red4(float x) { x += dppmov<0xB1>(x); x += dppmov<0x4E>(x); return x; }
DI int sgpr_opaque(int v) { asm volatile("" : "+s"(v)); return v; }
#define BIDX() sgpr_opaque((int)__builtin_amdgcn_workgroup_id_x())
#define GDIM() sgpr_opaque((int)__ockl_get_num_groups(0))
DI int tid_opaque() { int t = threadIdx.x; asm volatile("" : "+v"(t)); return t; }
DI float wave_sum(float v) {
#pragma unroll
    for (int o = 1; o < 64; o <<= 1) v += __shfl_xor(v, o);
    return v;
}
DI int tok_of(int d, int i) { if (i < LC) return d ? (LC - 1 - i) : i; return d ? (LC + SL - 1 - (i - LC)) : i; }
DI float* zrow(unsigned char* ws, float* out, int m) {
    const int b = m / T, t = m - b * T;
    return t < LC ? (float*)(ws + WS_ZC) + (size_t)(b * LC + t) * D : out + (size_t)(b * SL + t - LC) * D;
}
DI const float* modp(const unsigned char* ws, int layer, int who, int idx) { return (const float*)(ws + WS_MOD) + ((size_t)(layer * 9 + who) * 6 + idx) * D; }

template <int NT, int KS>
DI void mm16(const LAS bf16_t* A, int lda, const LAS bf16_t* B, int ldb, f32x4 (&acc)[NT], int fr, int fq) {
#pragma unroll
    for (int ks = 0; ks < KS; ++ks) {
        const bf16x8 a = *(const LAS bf16x8*)(A + fr * lda + ks * 32 + fq * 8);
#pragma unroll
        for (int nt = 0; nt < NT; ++nt) {
            const bf16x8 b = *(const LAS bf16x8*)(B + (nt * 16 + fr) * ldb + ks * 32 + fq * 8);
            acc[nt] = __builtin_amdgcn_mfma_f32_16x16x32_bf16(b, a, acc[nt], 0, 0, 0);
        }
    }
}

namespace pg8 {
constexpr int BM = 256, BK = 64, HALF = 128, HTB = HALF * BK * 2, NXCD = 8, WGM = 8;
__host__ __device__ __forceinline__ int lds_byte(int r, int c) { const int st = (r >> 4) * 2 + (c >> 5), rr = r & 15, cc = c & 31, ob = rr * 64 + cc * 2; return st * 1024 + (ob ^ (((ob >> 9) & 1) << 5)); }
__host__ __device__ __forceinline__ void stage_rc(int b, int& R, int& C) { const int st = b / 1024, sb = b % 1024, swz = sb ^ (((sb >> 9) & 1) << 5); R = (st >> 1) * 16 + swz / 64; C = (st & 1) * 32 + (swz % 64) / 2; }
__host__ __device__ __forceinline__ int perm32(int rho) { const int n = rho >> 4, i = rho & 15; return 8 * (i >> 2) + 4 * n + (i & 3); }
struct Unit { int pm, pn; };
struct StaticOrder {
    int nM, nN, nwg, G, c, skipctx;
    __device__ void init(int nM_, int nN_, int G_, int c_, int skipctx_ = 0) { skipctx = skipctx_; nM = skipctx_ ? nM_ / 17 * 16 : nM_; nN = nN_; nwg = nM * nN; G = G_; c = c_; }
    __device__ bool next(int i, Unit& u) const {
        const long L = (long)i * G + c; if (L >= nwg) return false;
        int wgid = (int)L; { const int q = nwg / NXCD, r = nwg % NXCD, xcd = wgid % NXCD, off = wgid / NXCD; wgid = (xcd < r ? xcd * (q + 1) : r * (q + 1) + (xcd - r) * q) + off; }
        const int nig = WGM * nN, gid = wgid / nig, fm = gid * WGM, gsz = (nM - fm) < WGM ? (nM - fm) : WGM;
        u.pm = fm + ((wgid % nig) % gsz); u.pn = (wgid % nig) / gsz; if (skipctx) u.pm = (u.pm >> 4) * 17 + 1 + (u.pm & 15); return true;
    }
};
DI unsigned cvt_pk_bf16(float lo, float hi) { unsigned r; asm volatile("v_cvt_pk_bf16_f32 %0, %1, %2" : "=v"(r) : "v"(lo), "v"(hi)); return r; }

template <class AF, class Epi>
DI void gemm_phase(LAS unsigned char* lds, const AF& af, const bf16_t* Bt, int lda, int K, const StaticOrder& S, const Epi& E) {
    const int tid = tid_opaque(), wid = __builtin_amdgcn_readfirstlane(tid >> 6), lane = tid & 63, wr = wid >> 2, wc = wid & 3, fr = lane & 15, fq = lane >> 4;
    const int nt = K / BK;
    unsigned voffA[2], voffB[2];
#pragma unroll
    for (int i = 0; i < 2; ++i) { int R, C; stage_rc(tid * 16 + i * 8192, R, C); const int Rb = (R & ~31) + perm32(R & 31);
        voffA[i] = (unsigned)(R * lda + C) * 2u; voffB[i] = (unsigned)(Rb * K + C) * 2u; }
    const size_t kstep = (size_t)(BK * 2);
    const size_t hstepA = (size_t)HALF * lda * 2, hstepB = (size_t)HALF * K * 2;
    const unsigned ldsw = (unsigned)wid * 1024u;
    const int aoff = lds_byte(wr * 64 + fr, fq * 8), boff = lds_byte(wc * 32 + fr, fq * 8);
#define PG8_SA(b, h) (((b) * 2 + (h)) * HTB)
#define PG8_SB(b, h) ((4 + (b) * 2 + (h)) * HTB)
#define PG8_STAGE(bufoff, gbase, voff) do { _Pragma("unroll") for (int _i = 0; _i < 2; ++_i) \
        __builtin_amdgcn_global_load_lds((const unsigned*)((const char*)(gbase) + (voff)[_i]), (LAS unsigned*)(lds + (bufoff) + ldsw + _i * 8192), 16, 0, 0); } while (0)
#define PG8_LDA(dst, b, h) do { _Pragma("unroll") for (int m = 0; m < 4; ++m) _Pragma("unroll") for (int k = 0; k < 2; ++k) dst[m][k] = *(const LAS bf16x8*)(lds + PG8_SA(b, h) + aoff + m * 2048 + k * 1024); } while (0)
#define PG8_LDB(dst, b, h) do { _Pragma("unroll") for (int n = 0; n < 2; ++n) _Pragma("unroll") for (int k = 0; k < 2; ++k) dst[n][k] = *(const LAS bf16x8*)(lds + PG8_SB(b, h) + boff + n * 2048 + k * 1024); } while (0)
#define PG8_MMA(ai, bj, At, Bt_) do { __builtin_amdgcn_s_setprio(1); _Pragma("unroll") for (int m = 0; m < 4; ++m) _Pragma("unroll") for (int n = 0; n < 2; ++n) _Pragma("unroll") for (int k = 0; k < 2; ++k) \
        acc[ai][bj][m][n] = __builtin_amdgcn_mfma_f32_16x16x32_bf16(Bt_[n][k], At[m][k], acc[ai][bj][m][n], 0, 0, 0); __builtin_amdgcn_s_setprio(0); } while (0)
#define PG8_WAIT_V(n) asm volatile("s_waitcnt vmcnt(" #n ")" ::: "memory")
#define PG8_WAIT_L(n) asm volatile("s_waitcnt lgkmcnt(" #n ")" ::: "memory")
#define PG8_BAR __builtin_amdgcn_s_barrier()
#define PG8_SCHED __builtin_amdgcn_sched_barrier(0)
    Unit cur, nxt; int ui = 0;
    if (!S.next(0, cur)) return;
    f32x4 acc[2][2][4][2];
#pragma unroll
    for (int a = 0; a < 2; ++a)
#pragma unroll
        for (int b = 0; b < 2; ++b)
#pragma unroll
            for (int m = 0; m < 4; ++m)
#pragma unroll
                for (int n = 0; n < 2; ++n) acc[a][b][m][n] = (f32x4){0.f, 0.f, 0.f, 0.f};
    bf16x8 At[4][2], B0[2][2], B1[2][2];
    const char* cA = af.a(cur.pm, cur.pn); const char* cB = (const char*)Bt + (size_t)cur.pn * 2 * hstepB;
    PG8_STAGE(PG8_SB(0, 0), cB, voffB); PG8_STAGE(PG8_SB(0, 1), cB + hstepB, voffB); PG8_STAGE(PG8_SA(0, 0), cA, voffA); PG8_STAGE(PG8_SA(0, 1), cA + hstepA, voffA);
    if (wr == 1) PG8_BAR;
    PG8_WAIT_V(2); PG8_BAR;
    PG8_STAGE(PG8_SB(1, 0), cB + kstep, voffB); PG8_STAGE(PG8_SA(1, 0), cA + kstep, voffA); PG8_STAGE(PG8_SB(1, 1), cB + hstepB + kstep, voffB);
    PG8_WAIT_V(6); PG8_BAR;
    for (;;) {
        const bool has_next = S.next(ui + 1, nxt);
        const char* nA = has_next ? af.a(nxt.pm, nxt.pn) : cA; const char* nB = has_next ? (const char*)Bt + (size_t)nxt.pn * 2 * hstepB : cB;
        for (int t = 0; t < nt; t += 2) {
            const bool last = (t == nt - 2);
            const char* a1 = cA + (size_t)(t + 1) * kstep;
            const char* a2 = last ? nA : cA + (size_t)(t + 2) * kstep; const char* b2 = last ? nB : cB + (size_t)(t + 2) * kstep;
            const char* a3 = a2 + kstep; const char* b3 = b2 + kstep;
            PG8_LDB(B0, 0, 0); PG8_LDB(B1, 0, 1); PG8_SCHED; PG8_LDA(At, 0, 0); PG8_STAGE(PG8_SA(1, 1), a1 + hstepA, voffA);
            PG8_WAIT_V(8); PG8_WAIT_L(0); PG8_BAR; PG8_MMA(0, 0, At, B0); PG8_MMA(0, 1, At, B1); PG8_BAR; PG8_SCHED;
            PG8_LDA(At, 0, 1); PG8_STAGE(PG8_SB(0, 0), b2, voffB); PG8_STAGE(PG8_SB(0, 1), b2 + hstepB, voffB); PG8_STAGE(PG8_SA(0, 0), a2, voffA);
            PG8_WAIT_V(8); PG8_WAIT_L(0); PG8_BAR; PG8_MMA(1, 0, At, B0); PG8_MMA(1, 1, At, B1); PG8_BAR; PG8_SCHED;
            PG8_LDB(B0, 1, 0); PG8_LDB(B1, 1, 1); PG8_SCHED; PG8_LDA(At, 1, 0); PG8_STAGE(PG8_SA(0, 1), a2 + hstepA, voffA);
            PG8_WAIT_V(8); PG8_WAIT_L(0); PG8_BAR; PG8_MMA(0, 0, At, B0); PG8_MMA(0, 1, At, B1); PG8_BAR; PG8_SCHED;
            PG8_LDA(At, 1, 1); PG8_STAGE(PG8_SB(1, 0), b3, voffB); PG8_STAGE(PG8_SB(1, 1), b3 + hstepB, voffB); PG8_STAGE(PG8_SA(1, 0), a3, voffA);
            PG8_WAIT_V(8); PG8_WAIT_L(0); PG8_BAR; PG8_MMA(1, 0, At, B0); PG8_MMA(1, 1, At, B1); PG8_BAR; PG8_SCHED;
        }
        if (wr == 0) PG8_BAR;
        E(acc, cur, wr, wc, fr, fq);
        if (!has_next) break;
#pragma unroll
        for (int a = 0; a < 2; ++a)
#pragma unroll
            for (int b = 0; b < 2; ++b)
#pragma unroll
                for (int m = 0; m < 4; ++m)
#pragma unroll
                    for (int n = 0; n < 2; ++n) acc[a][b][m][n] = (f32x4){0.f, 0.f, 0.f, 0.f};
        cur = nxt; cA = nA; cB = nB; ++ui;
        if (wr == 1) PG8_BAR;
    }
    PG8_WAIT_V(0);
    PG8_BAR;
#undef PG8_SA
#undef PG8_SB
#undef PG8_STAGE
#undef PG8_LDA
#undef PG8_LDB
#undef PG8_MMA
#undef PG8_WAIT_V
#undef PG8_WAIT_L
#undef PG8_BAR
#undef PG8_SCHED
}
}
using pg8::Unit;

struct ADense { const bf16_t* A; int lda; DI const char* a(int pm, int) const { return (const char*)(A + (size_t)pm * 256 * lda); } };
struct ARwkv { const bf16_t* X; DI const char* a(int pm, int pn) const {
        const int sel = pn < 4 ? 0 : pn < 8 ? 2 : pn < 12 ? 3 : pn == 12 ? 1 : pn == 13 ? 4 : 5;
        return (const char*)(X + (size_t)sel * QROWS * D + (size_t)pm * 256 * D); } };

DI int evmap(int n) {
    if (n < 512) return n; if (n < 1024) return 2064 + (n - 512); if (n < 1536) return 512 + (n - 1024); if (n < 2048) return 1024 + (n - 1536);
    if (n < 2560) return 1536 + (n - 2048); if (n < 2688) return 2576 + (n - 2560); if (n < 2816) return 2704 + (n - 2688); if (n < 2832) return 2048 + (n - 2816); return -1;
}
struct EpiEvenIn {
    bf16_t* Pb; float* G; const float* bias;
    DI void operator()(const f32x4 (&acc)[2][2][4][2], const Unit& u, int wr, int wc, int fr, int fq) const {
        const int row0 = u.pm * 256 + wr * 64 + fr;
#pragma unroll
        for (int bj = 0; bj < 2; ++bj) {
            const int col = u.pn * 256 + bj * 128 + wc * 32 + 8 * fq;
            const int oc = evmap(col);
            if (oc < 0) continue;
            const f32x4 b0 = *(const f32x4*)(bias + oc), b1 = *(const f32x4*)(bias + oc + 4);
#pragma unroll
            for (int ai = 0; ai < 2; ++ai)
#pragma unroll
                for (int m = 0; m < 4; ++m) {
                    const int row = row0 + ai * 128 + m * 16;
                    const f32x4 v0 = acc[ai][bj][m][0] + b0, v1 = acc[ai][bj][m][1] + b1;
                    if (col < 2816) { u32x4 w; w.x = pg8::cvt_pk_bf16(v0[0], v0[1]); w.y = pg8::cvt_pk_bf16(v0[2], v0[3]); w.z = pg8::cvt_pk_bf16(v1[0], v1[1]); w.w = pg8::cvt_pk_bf16(v1[2], v1[3]);
                        *(u32x4*)(Pb + (size_t)row * PW + col) = w; }
                    else { float* g = G + (size_t)row * 16 + (col - 2816); *(f32x4*)g = v0; *(f32x4*)(g + 4) = v1; }
                }
        }
    }
};
struct EpiRelu2 {
    bf16_t* O; int ldc;
    DI void operator()(const f32x4 (&acc)[2][2][4][2], const Unit& u, int wr, int wc, int fr, int fq) const {
        const int row0 = u.pm * 256 + wr * 64 + fr, col0 = u.pn * 256 + wc * 32 + 8 * fq;
#pragma unroll
        for (int ai = 0; ai < 2; ++ai)
#pragma unroll
            for (int m = 0; m < 4; ++m)
#pragma unroll
                for (int bj = 0; bj < 2; ++bj) {
                    f32x4 v0 = acc[ai][bj][m][0], v1 = acc[ai][bj][m][1];
#pragma unroll
                    for (int e = 0; e < 4; ++e) { float a = fmaxf(v0[e], 0.f); v0[e] = a * a; float b = fmaxf(v1[e], 0.f); v1[e] = b * b; }
                    u32x4 w; w.x = pg8::cvt_pk_bf16(v0[0], v0[1]); w.y = pg8::cvt_pk_bf16(v0[2], v0[3]); w.z = pg8::cvt_pk_bf16(v1[0], v1[1]); w.w = pg8::cvt_pk_bf16(v1[2], v1[3]);
                    *(u32x4*)(O + (size_t)(row0 + ai * 128 + m * 16) * ldc + col0 + bj * 128) = w;
                }
    }
};
struct EpiResid {
    unsigned char* ws; float* out; int layer, gidx;
    DI void operator()(const f32x4 (&acc)[2][2][4][2], const Unit& u, int wr, int wc, int fr, int fq) const {
        const int b = u.pm / 17, jt = u.pm - b * 17;
        const int who = jt == 0 ? 8 : b;
        const float* gate = modp(ws, layer, who, gidx);
        float* zb = jt == 0 ? (float*)(ws + WS_ZC) + (size_t)(b * LC) * D : out + (size_t)(b * SL + (jt - 1) * 256) * D;
        const int r0 = wr * 64 + fr, col0 = u.pn * 256 + wc * 32 + 8 * fq;
#pragma unroll
        for (int ai = 0; ai < 2; ++ai)
#pragma unroll
            for (int m = 0; m < 4; ++m)
#pragma unroll
                for (int bj = 0; bj < 2; ++bj) {
                    const int col = col0 + bj * 128;
                    const f32x4 g0 = *(const f32x4*)(gate + col), g1 = *(const f32x4*)(gate + col + 4);
                    float* zp = zb + (size_t)(r0 + ai * 128 + m * 16) * D + col;
                    f32x4 z0 = *(f32x4*)zp, z1 = *(f32x4*)(zp + 4);
                    z0 += g0 * acc[ai][bj][m][0]; z1 += g1 * acc[ai][bj][m][1];
                    *(f32x4*)zp = z0; *(f32x4*)(zp + 4) = z1;
                    __builtin_amdgcn_sched_barrier(0);
                }
    }
};
struct EpiRwkv {
    bf16_t* RKV; bf16_t* L1; bf16_t* G1; int rowbase;
    DI void operator()(const f32x4 (&acc)[2][2][4][2], const Unit& u, int wr, int wc, int fr, int fq) const {
        const int row0 = rowbase + u.pm * 256 + wr * 64 + fr;
#pragma unroll
        for (int bj = 0; bj < 2; ++bj) {
            const int c = bj * 128 + wc * 32 + 8 * fq;
            if (u.pn >= 12 && u.pn < 14 && bj == 1) continue;
#pragma unroll
            for (int ai = 0; ai < 2; ++ai)
#pragma unroll
                for (int m = 0; m < 4; ++m) {
                    const int row = row0 + ai * 128 + m * 16;
                    f32x4 v0 = acc[ai][bj][m][0], v1 = acc[ai][bj][m][1];
                    bf16_t* dst;
                    if (u.pn < 12) dst = RKV + (size_t)(u.pn >> 2) * M * D + (size_t)row * D + (u.pn & 3) * 256 + c;
                    else if (u.pn == 12) {
#pragma unroll
                        for (int e = 0; e < 4; ++e) { v0[e] = tanhf_(v0[e]); v1[e] = tanhf_(v1[e]); }
                        dst = L1 + (size_t)row * 256 + c;
                    } else if (u.pn == 13) dst = L1 + (size_t)row * 256 + 128 + c;
                    else {
#pragma unroll
                        for (int e = 0; e < 4; ++e) { v0[e] = c < 160 ? sigmoidf_(v0[e]) : 0.f; v1[e] = c < 160 ? sigmoidf_(v1[e]) : 0.f; }
                        dst = G1 + (size_t)row * 256 + c;
                    }
                    u32x4 w; w.x = pg8::cvt_pk_bf16(v0[0], v0[1]); w.y = pg8::cvt_pk_bf16(v0[2], v0[3]); w.z = pg8::cvt_pk_bf16(v1[0], v1[1]); w.w = pg8::cvt_pk_bf16(v1[2], v1[3]);
                    *(u32x4*)dst = w;
                }
        }
    }
};

DI int colmap(int kind, int n) {
    if (kind == 0) return n;
    if (kind == 1) return evmap(n);
    if (kind == 2) return n < 128 ? (n >> 6) * 65536 + (n & 63) : -1;
    return n < 160 ? n : -1;
}
DI void transpose_tiles(const float* src, int ldw, int Ks, bf16_t* dst, int Nn, int Kd, int kind, LAS float* tile) {
    const int tid = tid_opaque(), ntn = Nn / 64, ntk = Kd / 64;
    for (int it = BIDX(); it < ntn * ntk; it += GDIM()) {
        const int n0 = (it % ntn) * 64, k0 = (it / ntn) * 64;
        { const int nn = tid & 63, kk = tid >> 6; const int off = colmap(kind, n0 + nn);
#pragma unroll
          for (int i = 0; i < 8; ++i) { const int k = k0 + kk + 8 * i; float v = 0.f; if (off >= 0 && k < Ks) v = src[(size_t)k * ldw + off]; tile[(kk + 8 * i) * 65 + nn] = v; } }
        __syncthreads();
        { const int nn = tid >> 3, kc = tid & 7; const LAS float* s = tile + (kc * 8) * 65 + nn;
          u32x4 o; o.x = pk2(s[0], s[65]); o.y = pk2(s[2 * 65], s[3 * 65]); o.z = pk2(s[4 * 65], s[5 * 65]); o.w = pk2(s[6 * 65], s[7 * 65]);
          *(u32x4*)(dst + (size_t)(n0 + nn) * Kd + k0 + kc * 8) = o; }
        __syncthreads();
    }
}
DI void phase_setup(LAS unsigned char* lds) {
    const int tid = tid_opaque(), G = GDIM(); unsigned char* ws = WSP();
    { const size_t nx = (size_t)NB * SL * D / 4, nc = (size_t)NB * LC * D / 4;
      const f32x4* x4 = (const f32x4*)IN(0); f32x4* o4 = (f32x4*)OUTP();
      for (size_t i = (size_t)BIDX() * NTHREADS + tid; i < nx; i += (size_t)G * NTHREADS) o4[i] = x4[i];
      const f32x4* c4 = (const f32x4*)IN(2); f32x4* z4 = (f32x4*)(ws + WS_ZC);
      for (size_t i = (size_t)BIDX() * NTHREADS + tid; i < nc; i += (size_t)G * NTHREADS) z4[i] = c4[i]; }
    if (BIDX() == 0) { float* tab = (float*)(ws + WS_TAB);
        for (int e = tid; e < 1024; e += NTHREADS) { const int pos = e >> 4, i = e & 15;
            const float inv = exp2f(-(float)i * 0.83048202372184058696f);
            const float ang = (float)pos * inv; const float k = rintf(ang * 0.15915494309189533577f);
            float r = fmaf(-k, 6.28125f, ang); r = fmaf(-k, 1.9353071795864769e-3f, r);
            tab[e] = __cosf(r); tab[1024 + e] = __sinf(r); } }
    { LAS float* sv = (LAS float*)lds;
      LAS float* red = sv + 9 * 1024;
      { const float* cin = IN(1); const float* cctx = IN(3);
      for (int e = tid; e < 9 * 1024; e += NTHREADS) { const int who = e >> 10, k = e & 1023; const float c = who < 8 ? cin[who * D + k] : cctx[k]; sv[e] = c * sigmoidf_(c); } }
      const float* adaw = IN(4); const float* adab = IN(5);
      __syncthreads();
      for (int it = BIDX(); it < 4 * 48; it += G) {
          const int l = it / 48, n0 = (it % 48) * 128; const int kp = tid >> 7, nn = tid & 127;
          const float* w = adaw + (size_t)l * D * 6144 + n0 + nn;
          float a[9];
#pragma unroll
          for (int i = 0; i < 9; ++i) a[i] = 0.f;
          for (int k = kp * 256; k < kp * 256 + 256; ++k) { const float wv = w[(size_t)k * 6144];
#pragma unroll
              for (int i = 0; i < 9; ++i) a[i] = fmaf(sv[i * 1024 + k], wv, a[i]); }
#pragma unroll
          for (int i = 0; i < 9; ++i) red[(kp * 9 + i) * 128 + nn] = a[i];
          __syncthreads();
          if (kp == 0) { const float bias = adab[l * 6144 + n0 + nn];
#pragma unroll
              for (int i = 0; i < 9; ++i) { const float s = red[i * 128 + nn] + red[(9 + i) * 128 + nn] + red[(18 + i) * 128 + nn] + red[(27 + i) * 128 + nn];
                  ((float*)(ws + WS_MOD))[((size_t)(l * 9 + i)) * 6144 + n0 + nn] = s + bias; } }
          __syncthreads();
      } }
    LAS float* tile = (LAS float*)lds;
    for (int j = 0; j < 2; ++j) {
        transpose_tiles(IN(10) + (size_t)j * D * 2832, 2832, D, (bf16_t*)(ws + W_IN_T) + (size_t)j * 3072 * D, 3072, D, 1, tile);
        transpose_tiles(IN(12) + (size_t)j * D * D, D, D, (bf16_t*)(ws + W_EVO_T) + (size_t)j * D * D, D, D, 0, tile);
        for (int i = 0; i < 3; ++i) transpose_tiles(IN(19) + (size_t)(j * 3 + i) * D * D, D, D, (bf16_t*)(ws + W_RKVL_T) + (size_t)j * 3840 * D + (size_t)i * D * D, D, D, 0, tile);
        transpose_tiles(IN(21) + (size_t)j * 2 * D * 64, 64, D, (bf16_t*)(ws + W_RKVL_T) + (size_t)j * 3840 * D + (size_t)3072 * D, 256, D, 2, tile);
        transpose_tiles(IN(24) + (size_t)j * 2 * D * 64, 64, D, (bf16_t*)(ws + W_RKVL_T) + (size_t)j * 3840 * D + (size_t)3328 * D, 256, D, 2, tile);
        transpose_tiles(IN(26) + (size_t)j * D * 160, 160, D, (bf16_t*)(ws + W_RKVL_T) + (size_t)j * 3840 * D + (size_t)3584 * D, 256, D, 3, tile);
        for (int d = 0; d < 2; ++d) {
            transpose_tiles(IN(22) + (size_t)(j * 2 + d) * 64 * D, D, 64, (bf16_t*)(ws + W_2W_T) + (size_t)(j * 2 + d) * D * 64, D, 64, 0, tile);
            transpose_tiles(IN(25) + (size_t)(j * 2 + d) * 64 * D, D, 64, (bf16_t*)(ws + W_2A_T) + (size_t)(j * 2 + d) * D * 64, D, 64, 0, tile);
        }
        transpose_tiles(IN(27) + (size_t)j * 160 * D, D, 160, (bf16_t*)(ws + W_G2_T) + (size_t)j * D * 192, D, 192, 0, tile);
        transpose_tiles(IN(33) + (size_t)j * D * D, D, D, (bf16_t*)(ws + W_RWO_T) + (size_t)j * D * D, D, D, 0, tile);
    }
    for (int l = 0; l < 4; ++l) {
        transpose_tiles(IN(8) + (size_t)l * D * FF, FF, D, (bf16_t*)(ws + W_M1_T) + (size_t)l * FF * D, FF, D, 0, tile);
        transpose_tiles(IN(9) + (size_t)l * FF * D, D, FF, (bf16_t*)(ws + W_M2_T) + (size_t)l * D * FF, D, FF, 0, tile);
    }
}

DI void phase_norm(int layer, const float* g, int sidx, bf16_t* dst) {
    const int tid0 = tid_opaque(); const int lane = tid0 & 63, wave = tid0 >> 6; unsigned char* ws = WSP(); float* outp = OUTP();
    const int nw = GDIM() * 8;
    for (int m0 = BIDX() * 8 + wave; m0 < M; m0 += 2 * nw) {
        const int m1 = m0 + nw; const bool has1 = m1 < M; const int m1c = has1 ? m1 : m0;
        const float* z0 = zrow(ws, outp, m0); const float* z1 = zrow(ws, outp, m1c);
        f32x4 v0[4], v1[4]; float ss0 = 0.f, ss1 = 0.f;
#pragma unroll
        for (int j = 0; j < 4; ++j) { v0[j] = *(const f32x4*)(z0 + 4 * lane + 256 * j); v1[j] = *(const f32x4*)(z1 + 4 * lane + 256 * j); }
#pragma unroll
        for (int j = 0; j < 4; ++j) { ss0 += v0[j][0] * v0[j][0] + v0[j][1] * v0[j][1] + v0[j][2] * v0[j][2] + v0[j][3] * v0[j][3]; ss1 += v1[j][0] * v1[j][0] + v1[j][1] * v1[j][1] + v1[j][2] * v1[j][2] + v1[j][3] * v1[j][3]; }
#pragma unroll
        for (int o = 1; o < 64; o <<= 1) { ss0 += __shfl_xor(ss0, o); ss1 += __shfl_xor(ss1, o); }
#pragma unroll
        for (int r = 0; r < 2; ++r) {
            if (r == 1 && !has1) break;
            const int m = r ? m1 : m0; const int b = m / T, t = m - b * T; const int who = t < LC ? 8 : b;
            const float* sh = modp(ws, layer, who, sidx); const float* sc = modp(ws, layer, who, sidx + 1);
            const float rstd = rsqrtf((r ? ss1 : ss0) * (1.f / D) + 1e-6f);
#pragma unroll
            for (int j = 0; j < 4; ++j) { const int c = 4 * lane + 256 * j;
                const f32x4 gg = *(const f32x4*)(g + c), s1 = *(const f32x4*)(sc + c), s0 = *(const f32x4*)(sh + c);
                f32x4 y = (r ? v1[j] : v0[j]) * rstd * gg; y = y * (s1 + 1.f) + s0;
                u32x2 w; w.x = pk2(y[0], y[1]); w.y = pk2(y[2], y[3]);
                *(u32x2*)(dst + (size_t)m * D + c) = w; }
        }
    }
}

DI void mlstm_item(int j, int item, LAS unsigned char* lds) {
    unsigned char* ws = WSP();
    const int tid = tid_opaque(), wave = __builtin_amdgcn_readfirstlane(tid >> 6), lane = tid & 63, fr = lane & 15, fq = lane >> 4;
    const int b = item >> 5, head = (item >> 3) & 3, d = (item >> 2) & 1, vq = item & 3;
    LAS bf16_t* Qs = (LAS bf16_t*)lds; LAS bf16_t* KPs = Qs + 128 * 136; LAS bf16_t* KTs = KPs + 128 * 136;
    LAS bf16_t* VTs = KTs + 128 * 136; LAS bf16_t* VWs = VTs + 48 * 136; LAS bf16_t* Cs = VWs + 48 * 136;
    LAS float* lfs = (LAS float*)(Cs + 48 * 136); LAS float* ics = lfs + 128; LAS float* gs = ics + 128; LAS float* bcs = gs + 128;
    LAS float* wss = bcs + 128; LAS float* ats = wss + 128; LAS float* scal = ats + 128;
    const bf16_t* Pb = (const bf16_t*)(ws + EV_P); const float* Gt = (const float*)(ws + EV_G);
    bf16_t* HB = (bf16_t*)(ws + EV_HB) + (size_t)d * M * 512;
    const float fb = IN(13)[(j * 2 + d) * 4 + head];
    const float scale = 0.08838834764831845f;
    __syncthreads();
    for (int e = tid; e < 48 * 136; e += NTHREADS) { const int r = e / 136; Cs[e] = 0; VWs[e] = 0; VTs[e] = (r == 32) ? (bf16_t)0x3F80 : (bf16_t)0; }
    f32x4 Ct[3];
#pragma unroll
    for (int i = 0; i < 3; ++i) Ct[i] = (f32x4){0.f, 0.f, 0.f, 0.f};
    float mst = 0.f;
    const int prow_ = tid >> 2, pcs_ = tid & 3;
    float pgi = 0.f, pgf = 0.f; u32x4 pq[4], pk[4], pv;
    { if (tid < 128) { const int mr = b * T + tok_of(d, tid); pgi = Gt[(size_t)mr * 16 + d * 8 + head]; pgf = Gt[(size_t)mr * 16 + d * 8 + 4 + head]; }
      const bf16_t* s0_ = Pb + (size_t)(b * T + tok_of(d, prow_)) * PW + head * 128;
#pragma unroll
      for (int i = 0; i < 4; ++i) { pq[i] = *(const u32x4*)(s0_ + pcs_ * 32 + i * 8); pk[i] = *(const u32x4*)(s0_ + 1024 + pcs_ * 32 + i * 8); }
      pv = *(const u32x4*)(s0_ + 1536 + vq * 32 + pcs_ * 8); }
    for (int p = 0; p < 34; ++p) {
        const int i0 = p * 128;
        if (tid < 128) { ics[tid] = softcap_(pgi); const float x = softcap_(pgf + fb); lfs[tid] = -__logf(1.f + __expf(-x)); }
        __syncthreads();
        if (wave == 0) {
            const float a0 = lfs[2 * lane], a1 = lfs[2 * lane + 1]; const float c1 = a0 + a1;
            float x = c1;
#pragma unroll
            for (int o = 1; o < 64; o <<= 1) { const float y = __shfl_up(x, o); if (lane >= o) x += y; }
            const float ex = x - c1; const float bc0 = ex + a0, bc1 = ex + c1;
            const float g0 = ics[2 * lane] - bc0, g1 = ics[2 * lane + 1] - bc1;
            float pm = fmaxf(g0, g1);
#pragma unroll
            for (int o = 1; o < 64; o <<= 1) { const float y = __shfl_up(pm, o); if (lane >= o) pm = fmaxf(pm, y); }
            float pe = __shfl_up(pm, 1); if (lane == 0) pe = -3.0e38f;
            const float pm0 = fmaxf(pe, g0), pm1 = fmaxf(pe, fmaxf(g0, g1));
            const float bl = __shfl(x, 63), gmax = __shfl(pm, 63);
            const float mnew = fmaxf(bl + mst, bl + gmax);
            bcs[2 * lane] = bc0; bcs[2 * lane + 1] = bc1; gs[2 * lane] = g0; gs[2 * lane + 1] = g1;
            ats[2 * lane] = fmaxf(pm0, mst); ats[2 * lane + 1] = fmaxf(pm1, mst);
            wss[2 * lane] = __expf(bl + g0 - mnew) * scale; wss[2 * lane + 1] = __expf(bl + g1 - mnew) * scale;
            if (lane == 0) { scal[0] = mnew; scal[1] = __expf(bl + mst - mnew); }
        }
        __syncthreads();
        const float mnew = scal[0], carry = scal[1];
        {
            const int row = prow_, cs = pcs_;
#pragma unroll
            for (int i = 0; i < 4; ++i) { const u32x4 q = pq[i]; *(LAS u32x4*)(Qs + row * 136 + cs * 32 + i * 8) = q; }
#pragma unroll
            for (int i = 0; i < 4; ++i) { const u32x4 k = pk[i]; *(LAS u32x4*)(KPs + row * 136 + cs * 32 + i * 8) = k;
                const int c0 = cs * 32 + i * 8;
                KTs[(c0 + 0) * 136 + row] = (bf16_t)(k.x & 0xffff); KTs[(c0 + 1) * 136 + row] = (bf16_t)(k.x >> 16);
                KTs[(c0 + 2) * 136 + row] = (bf16_t)(k.y & 0xffff); KTs[(c0 + 3) * 136 + row] = (bf16_t)(k.y >> 16);
                KTs[(c0 + 4) * 136 + row] = (bf16_t)(k.z & 0xffff); KTs[(c0 + 5) * 136 + row] = (bf16_t)(k.z >> 16);
                KTs[(c0 + 6) * 136 + row] = (bf16_t)(k.w & 0xffff); KTs[(c0 + 7) * 136 + row] = (bf16_t)(k.w >> 16); }
            const u32x4 v = pv; const float ws = wss[row];
            const unsigned vv[4] = {v.x, v.y, v.z, v.w};
#pragma unroll
            for (int e = 0; e < 4; ++e) { const int c0 = cs * 8 + 2 * e;
                VTs[c0 * 136 + row] = (bf16_t)(vv[e] & 0xffff); VTs[(c0 + 1) * 136 + row] = (bf16_t)(vv[e] >> 16);
                VWs[c0 * 136 + row] = (bf16_t)f2bf(bflo(vv[e]) * ws); VWs[(c0 + 1) * 136 + row] = (bf16_t)f2bf(bfhi(vv[e]) * ws); }
            if (tid < 128) VWs[32 * 136 + tid] = (bf16_t)f2bf(wss[tid]);
            if (p + 1 < 34) {
                if (tid < 128) { const int mr = b * T + tok_of(d, i0 + 128 + tid); pgi = Gt[(size_t)mr * 16 + d * 8 + head]; pgf = Gt[(size_t)mr * 16 + d * 8 + 4 + head]; }
                const bf16_t* sn_ = Pb + (size_t)(b * T + tok_of(d, i0 + 128 + prow_)) * PW + head * 128;
#pragma unroll
                for (int i = 0; i < 4; ++i) { pq[i] = *(const u32x4*)(sn_ + pcs_ * 32 + i * 8); pk[i] = *(const u32x4*)(sn_ + 1024 + pcs_ * 32 + i * 8); }
                pv = *(const u32x4*)(sn_ + 1536 + vq * 32 + pcs_ * 8);
            }
        }
        __syncthreads();
        f32x4 s[8];
#pragma unroll
        for (int i = 0; i < 8; ++i) s[i] = (f32x4){0.f, 0.f, 0.f, 0.f};
        mm16<8, 4>(Qs + wave * 16 * 136, 136, KPs, 136, s, fr, fq);
        __syncthreads();
        const int trow = wave * 16 + fr; const float at = ats[trow];
#pragma unroll
        for (int nt = 0; nt < 8; ++nt) { const f32x4 g4 = *(const LAS f32x4*)(gs + nt * 16 + fq * 4); float o[4];
#pragma unroll
            for (int e = 0; e < 4; ++e) { const int sc = nt * 16 + fq * 4 + e; const float w = __expf(fminf(g4[e] - at, 0.f)); o[e] = (sc <= trow) ? s[nt][e] * scale * w : 0.f; }
            u32x2 w2; w2.x = pk2(o[0], o[1]); w2.y = pk2(o[2], o[3]);
            *(LAS u32x2*)(KPs + trow * 136 + nt * 16 + fq * 4) = w2; }
        __syncthreads();
        f32x4 num[3], num2[3];
#pragma unroll
        for (int i = 0; i < 3; ++i) { num[i] = (f32x4){0.f, 0.f, 0.f, 0.f}; num2[i] = (f32x4){0.f, 0.f, 0.f, 0.f}; }
        mm16<3, 4>(KPs + wave * 16 * 136, 136, VTs, 136, num, fr, fq);
        mm16<3, 4>(Qs + wave * 16 * 136, 136, Cs, 136, num2, fr, fq);
        {
            const float rs = __shfl(num[2][0], fr), qn = __shfl(num2[2][0], fr);
            const float iw = __expf(mst - at), mt = bcs[trow] + at;
            const float den = fmaxf(fabsf(rs + iw * qn), __expf(-mt)); const float inv = 1.f / den;
            const int mrow = b * T + tok_of(d, i0 + trow);
#pragma unroll
            for (int nt = 0; nt < 2; ++nt) { const f32x4 o = (num[nt] + num2[nt] * iw) * inv;
                u32x2 w2; w2.x = pk2(o[0], o[1]); w2.y = pk2(o[2], o[3]);
                *(u32x2*)(HB + (size_t)mrow * 512 + head * 128 + vq * 32 + nt * 16 + fq * 4) = w2; }
        }
#pragma unroll
        for (int i = 0; i < 3; ++i) Ct[i] *= carry;
        mm16<3, 4>(KTs + wave * 16 * 136, 136, VWs, 136, Ct, fr, fq);
        __syncthreads();
#pragma unroll
        for (int nt = 0; nt < 3; ++nt)
#pragma unroll
            for (int e = 0; e < 4; ++e) Cs[(nt * 16 + fq * 4 + e) * 136 + wave * 16 + fr] = (bf16_t)f2bf(Ct[nt][e]);
        mst = mnew;
    }
    __syncthreads();
}

DI void attn_load_head(const bf16_t* Pb, int coloff, int b, int t0, const float* g, bool rope, float scale, const float* tab, LAS bf16_t* dst) {
    const int tid = tid_opaque(), row = tid >> 2, q4 = tid & 3; const int t = t0 + row; const size_t mrow = (size_t)b * T + t;
    const bf16_t* src = Pb + mrow * PW + coloff;
    float y[4][4]; float ss = 0.f;
#pragma unroll
    for (int c = 0; c < 4; ++c) { const u32x2 u = *(const u32x2*)(src + c * 16 + q4 * 4); y[c][0] = bflo(u.x); y[c][1] = bfhi(u.x); y[c][2] = bflo(u.y); y[c][3] = bfhi(u.y);
#pragma unroll
        for (int e = 0; e < 4; ++e) ss += y[c][e] * y[c][e]; }
    ss = red4(ss); const float rstd = rsqrtf(ss * (1.f / 64.f) + 1e-6f);
#pragma unroll
    for (int c = 0; c < 4; ++c)
#pragma unroll
        for (int e = 0; e < 4; ++e) y[c][e] = y[c][e] * rstd * g[c * 16 + q4 * 4 + e];
    if (rope) { const int pos = t - LC, rp = pos >> 6, cp = pos & 63;
#pragma unroll
        for (int e = 0; e < 4; ++e) { const int i = q4 * 4 + e;
            { const float co = tab[rp * 16 + i], si = tab[1024 + rp * 16 + i]; const float x1 = y[0][e], x2 = y[1][e]; y[0][e] = x1 * co - x2 * si; y[1][e] = x1 * si + x2 * co; }
            { const float co = tab[cp * 16 + i], si = tab[1024 + cp * 16 + i]; const float x1 = y[2][e], x2 = y[3][e]; y[2][e] = x1 * co - x2 * si; y[3][e] = x1 * si + x2 * co; } } }
#pragma unroll
    for (int c = 0; c < 4; ++c) { u32x2 w; w.x = pk2(y[c][0] * scale, y[c][1] * scale); w.y = pk2(y[c][2] * scale, y[c][3] * scale);
        *(LAS u32x2*)(dst + row * 72 + c * 16 + q4 * 4) = w; }
}
DI void attn_tile(int j, int tile, LAS unsigned char* lds) {
    unsigned char* ws = WSP();
    const int tid = tid_opaque(), wave = __builtin_amdgcn_readfirstlane(tid >> 6), lane = tid & 63, fr = lane & 15, fq = lane >> 4;
    int b, kvh, qb; bool lat;
    if (tile < 512) { lat = true; b = tile >> 6; kvh = (tile >> 5) & 1; qb = tile & 31; } else { const int c = tile - 512; lat = false; b = c >> 2; kvh = (c >> 1) & 1; qb = c & 1; }
    LAS bf16_t* Qs = (LAS bf16_t*)lds; LAS bf16_t* Ks = Qs + 4 * 128 * 72; LAS bf16_t* VTs = Ks + 128 * 72; LAS bf16_t* Ps = VTs + 64 * 136;
    bf16_t* Pb = (bf16_t*)(ws + EV_P); const float* tab = (const float*)(ws + WS_TAB);
    const float* qg = IN(15) + j * 64; const float* kg = IN(16) + j * 64; const float* sinkp = IN(17) + j * 8 + kvh * 4;
    const int tq0 = lat ? LC + qb * 128 : qb * 128;
    __syncthreads();
    for (int g = 0; g < 4; ++g) attn_load_head(Pb, 512 + (kvh * 4 + g) * 64, b, tq0, qg, lat, 0.125f, tab, Qs + g * 128 * 72);
    f32x4 O[4][4]; float mr[4], lr[4];
#pragma unroll
    for (int g = 0; g < 4; ++g) { mr[g] = sinkp[g]; lr[g] = 1.f;
#pragma unroll
        for (int i = 0; i < 4; ++i) O[g][i] = (f32x4){0.f, 0.f, 0.f, 0.f}; }
    const int nkb = lat ? 5 : 2;
    for (int kb = 0; kb < nkb; ++kb) {
        int tk0; int mask = 0; bool krope = false;
        if (kb < 2) tk0 = kb * 128;
        else { const int kq = qb + (kb - 3); if (kq < 0 || kq > 31) continue; tk0 = LC + kq * 128; krope = true; mask = kb == 2 ? 1 : (kb == 4 ? 2 : 0); }
        __syncthreads();
        attn_load_head(Pb, 2560 + kvh * 64, b, tk0, kg, krope, 1.f, tab, Ks);
        { const int row = tid >> 2, q4 = tid & 3; const bf16_t* src = Pb + ((size_t)b * T + tk0 + row) * PW + 2688 + kvh * 64 + q4 * 16;
          const u32x4 v0 = *(const u32x4*)src, v1 = *(const u32x4*)(src + 8); const unsigned vv[8] = {v0.x, v0.y, v0.z, v0.w, v1.x, v1.y, v1.z, v1.w};
#pragma unroll
          for (int e = 0; e < 8; ++e) { VTs[(q4 * 16 + 2 * e) * 136 + row] = (bf16_t)(vv[e] & 0xffff); VTs[(q4 * 16 + 2 * e + 1) * 136 + row] = (bf16_t)(vv[e] >> 16); } }
        __syncthreads();
        const float sgnf = mask == 1 ? 1.f : (mask == 2 ? -1.f : 0.f);
        const float basef = (float)(fq * 4 - (wave * 16 + fr)) * sgnf;
#pragma unroll
        for (int g = 0; g < 4; ++g) {
            asm volatile("" ::: "memory");
            f32x4 s[8];
#pragma unroll
            for (int i = 0; i < 8; ++i) s[i] = (f32x4){0.f, 0.f, 0.f, 0.f};
            mm16<8, 2>(Qs + g * 128 * 72 + wave * 16 * 72, 72, Ks, 72, s, fr, fq);
            const int qi = wave * 16 + fr;
            float mx = -3.0e38f;
#pragma unroll
            for (int nt = 0; nt < 8; ++nt)
#pragma unroll
                for (int e = 0; e < 4; ++e) { const float tf = fmaf(sgnf, (float)(nt * 16 + e), basef);
                    s[nt][e] += fminf(tf, 0.f) * 1.0e30f; mx = fmaxf(mx, s[nt][e]); }
            mx = fmaxf(mx, __shfl_xor(mx, 16)); mx = fmaxf(mx, __shfl_xor(mx, 32));
            const float mn = fmaxf(mr[g], mx); const float alpha = __expf(mr[g] - mn);
            float rs = 0.f;
#pragma unroll
            for (int nt = 0; nt < 8; ++nt) { float o[4];
#pragma unroll
                for (int e = 0; e < 4; ++e) { o[e] = __expf(s[nt][e] - mn); rs += o[e]; }
                u32x2 w2; w2.x = pk2(o[0], o[1]); w2.y = pk2(o[2], o[3]);
                *(LAS u32x2*)(Ps + qi * 136 + nt * 16 + fq * 4) = w2; }
            rs += __shfl_xor(rs, 16); rs += __shfl_xor(rs, 32);
            lr[g] = lr[g] * alpha + rs; mr[g] = mn;
#pragma unroll
            for (int i = 0; i < 4; ++i) O[g][i] *= alpha;
            mm16<4, 4>(Ps + wave * 16 * 136, 136, VTs, 136, O[g], fr, fq);
        }
    }
    { const size_t mrow = (size_t)b * T + tq0 + wave * 16 + fr;
#pragma unroll
      for (int g = 0; g < 4; ++g) { const float inv = 1.f / lr[g];
#pragma unroll
          for (int nt = 0; nt < 4; ++nt) { const f32x4 o = O[g][nt] * inv; u32x2 w2; w2.x = pk2(o[0], o[1]); w2.y = pk2(o[2], o[3]);
              *(u32x2*)(Pb + mrow * PW + 512 + (kvh * 4 + g) * 64 + nt * 16 + fq * 4) = w2; } } }
    __syncthreads();
}

DI void phase_ml_combine(int j) {
    const int tid0 = tid_opaque(); const int lane = tid0 & 63, wave = tid0 >> 6; unsigned char* ws = WSP();
    bf16_t* Pb = (bf16_t*)(ws + EV_P); const bf16_t* H0 = (const bf16_t*)(ws + EV_HB); const bf16_t* H1 = H0 + (size_t)M * 512;
    const float* og = IN(14) + j * 512; const int nw = GDIM() * 8; const int col = lane * 8;
    float ogv[8];
#pragma unroll
    for (int e = 0; e < 8; ++e) ogv[e] = og[col + e];
    for (int m0 = BIDX() * 8 + wave; m0 < M; m0 += 2 * nw) {
        const int m1 = (m0 + nw < M) ? m0 + nw : m0; const bool has1 = m0 + nw < M;
        u32x4 a[2], c[2], o[2];
#pragma unroll
        for (int r = 0; r < 2; ++r) { const size_t m = r ? m1 : m0; a[r] = *(const u32x4*)(H0 + m * 512 + col); c[r] = *(const u32x4*)(H1 + m * 512 + col); o[r] = *(const u32x4*)(Pb + m * PW + 2048 + col); }
#pragma unroll
        for (int r = 0; r < 2; ++r) {
            if (r == 1 && !has1) break;
            const size_t m = r ? m1 : m0;
            const unsigned av[4] = {a[r].x, a[r].y, a[r].z, a[r].w}, cv[4] = {c[r].x, c[r].y, c[r].z, c[r].w}, ov[4] = {o[r].x, o[r].y, o[r].z, o[r].w};
            float s[8]; float ss = 0.f;
#pragma unroll
            for (int e = 0; e < 4; ++e) { s[2 * e] = bflo(av[e]) + bflo(cv[e]); s[2 * e + 1] = bfhi(av[e]) + bfhi(cv[e]); ss += s[2 * e] * s[2 * e] + s[2 * e + 1] * s[2 * e + 1]; }
            ss = red16(ss); const float rstd = rsqrtf(ss * (1.f / 128.f) + 1e-6f);
            unsigned w[4];
#pragma unroll
            for (int e = 0; e < 4; ++e) { const float y0 = s[2 * e] * rstd * ogv[2 * e] * sigmoidf_(bflo(ov[e])); const float y1 = s[2 * e + 1] * rstd * ogv[2 * e + 1] * sigmoidf_(bfhi(ov[e])); w[e] = pk2(y0, y1); }
            u32x4 wv; wv.x = w[0]; wv.y = w[1]; wv.z = w[2]; wv.w = w[3];
            *(u32x4*)(Pb + m * PW + col) = wv;
        }
    }
}

DI void phase_rw_mix(int layer, int j, int q, LAS unsigned char* lds) {
    const int tid = tid_opaque(), lane = tid & 63, wave = tid >> 6; unsigned char* ws = WSP(); float* outp = OUTP();
    LAS float* hs = (LAS float*)lds;
    const float* g = IN(6) + layer * D; const float* mu = IN(18) + (size_t)j * 12 * D;
    bf16_t* X = (bf16_t*)(ws + OD_XQ);
    for (int it = BIDX(); it < QROWS / 17; it += GDIM()) {
        const int lr0 = it * 17, m0 = q * QROWS + lr0; const int b = m0 / T, t0 = m0 - b * T;
        __syncthreads();
        for (int rr = wave; rr < 19; rr += 8) {
            const int t = t0 - 1 + rr;
            if (t < 0 || t >= T) {
#pragma unroll
                for (int jj = 0; jj < 4; ++jj) *(LAS f32x4*)(hs + rr * 1024 + 4 * lane + 256 * jj) = (f32x4){0.f, 0.f, 0.f, 0.f};
            } else {
                const int who = t < LC ? 8 : b; const float* sh = modp(ws, layer, who, 0); const float* sc = modp(ws, layer, who, 1);
                const float* z = zrow(ws, outp, b * T + t); f32x4 v[4]; float ss = 0.f;
#pragma unroll
                for (int jj = 0; jj < 4; ++jj) { v[jj] = *(const f32x4*)(z + 4 * lane + 256 * jj); ss += v[jj][0] * v[jj][0] + v[jj][1] * v[jj][1] + v[jj][2] * v[jj][2] + v[jj][3] * v[jj][3]; }
                const float rstd = rsqrtf(wave_sum(ss) * (1.f / D) + 1e-6f);
#pragma unroll
                for (int jj = 0; jj < 4; ++jj) { const int c = 4 * lane + 256 * jj;
                    const f32x4 gg = *(const f32x4*)(g + c), a1 = *(const f32x4*)(sc + c), a0 = *(const f32x4*)(sh + c);
                    f32x4 y = v[jj] * rstd * gg; y = y * (a1 + 1.f) + a0; *(LAS f32x4*)(hs + rr * 1024 + c) = y; }
            }
        }
        __syncthreads();
        const int c4 = tid & 255, rh = tid >> 8;
        f32x4 mu0[6], mu1[6];
#pragma unroll
        for (int i = 0; i < 6; ++i) { mu0[i] = *(const f32x4*)(mu + (size_t)(i * 2) * D + 4 * c4); mu1[i] = *(const f32x4*)(mu + (size_t)(i * 2 + 1) * D + 4 * c4); }
        for (int k = 0; k < 9; ++k) { const int r = rh + 2 * k; if (r >= 17) break;
            const int t = t0 + r;
            const f32x4 u = *(const LAS f32x4*)(hs + (r + 1) * 1024 + 4 * c4);
            f32x4 pv = *(const LAS f32x4*)(hs + r * 1024 + 4 * c4), nx = *(const LAS f32x4*)(hs + (r + 2) * 1024 + 4 * c4);
            if (t == 0 || t == LC) pv = (f32x4){0.f, 0.f, 0.f, 0.f};
            if (t == LC - 1 || t == T - 1) nx = (f32x4){0.f, 0.f, 0.f, 0.f};
            const f32x4 dp = pv - u, dn = nx - u;
#pragma unroll
            for (int i = 0; i < 6; ++i) { const f32x4 x = u + mu0[i] * dp + mu1[i] * dn; u32x2 w; w.x = pk2(x[0], x[1]); w.y = pk2(x[2], x[3]);
                *(u32x2*)(X + (size_t)i * QROWS * D + (size_t)(lr0 + r) * D + 4 * c4) = w; } }
    }
    __syncthreads();
}

DI void rwkv_scan_item(int j, int item, LAS unsigned char* lds) {
    unsigned char* ws = WSP();
    const int tid = tid_opaque(), wave = __builtin_amdgcn_readfirstlane(tid >> 6), lane = tid & 63, fr = lane & 15, fq = lane >> 4;
    const int b = item >> 5, head = (item >> 1) & 15, d = item & 1;
    LAS float* steps = (LAS float*)lds;
    LAS bf16_t* L1w = (LAS bf16_t*)(lds + 98304);
    LAS bf16_t* W2w = (LAS bf16_t*)(lds + 107008);
    LAS bf16_t* W2a = (LAS bf16_t*)(lds + 116224);
    LAS float* ybuf = (LAS float*)(lds + 125440);
    const bf16_t* R = (const bf16_t*)(ws + OD_RKV); const bf16_t* Kb = R + (size_t)M * D; const bf16_t* Vb = Kb + (size_t)M * D;
    const bf16_t* L1 = (const bf16_t*)(ws + OD_L1);
    bf16_t* Y = (bf16_t*)(ws + OD_Y) + (size_t)d * M * D; float* SB = (float*)(ws + OD_SB) + (size_t)d * M * 16;
    constexpr int NC = T / 32;
    __syncthreads();
    { const int n = tid >> 3, kc = tid & 7;
      const bf16_t* sw = (const bf16_t*)(ws + W_2W_T) + ((size_t)(j * 2 + d) * D + head * 64 + n) * 64 + kc * 8;
      const bf16_t* sa = (const bf16_t*)(ws + W_2A_T) + ((size_t)(j * 2 + d) * D + head * 64 + n) * 64 + kc * 8;
      *(LAS u32x4*)(W2w + n * 72 + kc * 8) = *(const u32x4*)sw; *(LAS u32x4*)(W2a + n * 72 + kc * 8) = *(const u32x4*)sa; }
    __syncthreads();
    const int rp = (tid >> 3) & 31, cg8 = tid & 7;
    f32x4 s0a = (f32x4){0.f, 0.f, 0.f, 0.f}, s0b = s0a, s1a = s0a, s1b = s0a;
    for (int c = -1; c <= NC; ++c) {
        if (wave < 4) {
            if (c >= 0 && c < NC) {
                const LAS float* sbuf = steps + (c & 1) * 12288; LAS float* yb = ybuf + (c & 1) * 2048;
#pragma unroll 4
                for (int t = 0; t < 32; ++t) {
                    const LAS float* st = sbuf + t * 384 + cg8 * 8;
                    const f32x4 w4a = *(const LAS f32x4*)(st), w4b = *(const LAS f32x4*)(st + 4), k4a = *(const LAS f32x4*)(st + 64), k4b = *(const LAS f32x4*)(st + 68),
                                a4a = *(const LAS f32x4*)(st + 128), a4b = *(const LAS f32x4*)(st + 132), b4a = *(const LAS f32x4*)(st + 192), b4b = *(const LAS f32x4*)(st + 196),
                                r4a = *(const LAS f32x4*)(st + 256), r4b = *(const LAS f32x4*)(st + 260);
                    const float v0 = sbuf[t * 384 + 320 + rp], v1 = sbuf[t * 384 + 320 + rp + 32];
                    f32x4 p0 = s0a * a4a + s0b * a4b, p1 = s1a * a4a + s1b * a4b;
                    const f32x2 qa0 = p0.xy + p0.zw, qa1 = p1.xy + p1.zw;
                    float sa0 = qa0.x + qa0.y, sa1 = qa1.x + qa1.y;
                    sa0 = red8(sa0); sa1 = red8(sa1);
                    s0a = s0a * w4a + b4a * sa0 + k4a * v0; s0b = s0b * w4b + b4b * sa0 + k4b * v0;
                    s1a = s1a * w4a + b4a * sa1 + k4a * v1; s1b = s1b * w4b + b4b * sa1 + k4b * v1;
                    p0 = s0a * r4a + s0b * r4b; p1 = s1a * r4a + s1b * r4b;
                    const f32x2 qy0 = p0.xy + p0.zw, qy1 = p1.xy + p1.zw;
                    float y0 = qy0.x + qy0.y, y1 = qy1.x + qy1.y;
                    y0 = red8(y0); y1 = red8(y1);
                    if (cg8 == 0) { yb[t * 64 + rp] = y0; yb[t * 64 + rp + 32] = y1; }
                }
            }
        } else if (wave < 6) {
            const int cn = c + 1;
            if (cn < NC) {
                const int pw = wave - 4, r0 = pw * 16, i0 = cn * 32;
                LAS float* sbuf = steps + (cn & 1) * 12288; LAS bf16_t* Lw = L1w + pw * 16 * 136;
                u32x4 l1v[4]; u32x2 kv[4], rv[4], vv[4];
#pragma unroll
                for (int i = 0; i < 4; ++i) { const int q = lane + 64 * i; const int row = q >> 4, cc = q & 15; const int sc = cc < 8 ? d * 64 + cc * 8 : 128 + d * 64 + (cc - 8) * 8;
                    const size_t mr = (size_t)b * T + tok_of(d, i0 + r0 + row);
                    l1v[i] = *(const u32x4*)(L1 + mr * 256 + sc); }
#pragma unroll
                for (int i = 0; i < 4; ++i) { const int row = i * 4 + fq; const size_t mr = (size_t)b * T + tok_of(d, i0 + r0 + row);
                    kv[i] = *(const u32x2*)(Kb + mr * D + head * 64 + fr * 4); rv[i] = *(const u32x2*)(R + mr * D + head * 64 + fr * 4); vv[i] = *(const u32x2*)(Vb + mr * D + head * 64 + fr * 4); }
#pragma unroll
                for (int i = 0; i < 4; ++i) { const int q = lane + 64 * i; *(LAS u32x4*)(Lw + (q >> 4) * 136 + (q & 15) * 8) = l1v[i]; }
                asm volatile("s_waitcnt lgkmcnt(0)" ::: "memory");
                const float* w0 = IN(20) + (size_t)(j * 2 + d) * D + head * 64; const float* a0 = IN(23) + (size_t)(j * 2 + d) * D + head * 64;
                { f32x4 acc[4];
#pragma unroll
                  for (int i = 0; i < 4; ++i) acc[i] = (f32x4){0.f, 0.f, 0.f, 0.f};
                  mm16<4, 2>(Lw, 136, W2w, 72, acc, fr, fq);
#pragma unroll
                  for (int nt = 0; nt < 4; ++nt) { const int ch = nt * 16 + fq * 4; f32x4 o;
#pragma unroll
                      for (int e = 0; e < 4; ++e) { const float wp = w0[ch + e] + acc[nt][e]; const float wl = -__logf(1.f + __expf(-wp)) - 0.5f; o[e] = __expf(-__expf(wl)); }
                      *(LAS f32x4*)(sbuf + (r0 + fr) * 384 + ch) = o; } }
                { f32x4 acc[4];
#pragma unroll
                  for (int i = 0; i < 4; ++i) acc[i] = (f32x4){0.f, 0.f, 0.f, 0.f};
                  mm16<4, 2>(Lw + 64, 136, W2a, 72, acc, fr, fq);
#pragma unroll
                  for (int nt = 0; nt < 4; ++nt) { const int ch = nt * 16 + fq * 4; f32x4 o;
#pragma unroll
                      for (int e = 0; e < 4; ++e) o[e] = sigmoidf_(a0[ch + e] + acc[nt][e]);
                      *(LAS f32x4*)(sbuf + (r0 + fr) * 384 + 128 + ch) = o; } }
                asm volatile("s_waitcnt lgkmcnt(0)" ::: "memory");
                const float* kkw = IN(28) + j * D + head * 64; const float* kaw = IN(29) + j * D + head * 64; const float* rkw = IN(30) + (j * 16 + head) * 64;
#pragma unroll
                for (int i = 0; i < 4; ++i) {
                    const int row = r0 + i * 4 + fq, ch = fr * 4; const size_t mr = (size_t)b * T + tok_of(d, i0 + row);
                    const u32x2 ku = kv[i], ru = rv[i], vu = vv[i];
                    const float kf[4] = {bflo(ku.x), bfhi(ku.x), bflo(ku.y), bfhi(ku.y)}, rf[4] = {bflo(ru.x), bfhi(ru.x), bflo(ru.y), bfhi(ru.y)}, vf[4] = {bflo(vu.x), bfhi(vu.x), bflo(vu.y), bfhi(vu.y)};
                    LAS float* st = sbuf + row * 384;
                    const f32x4 as = *(const LAS f32x4*)(st + 128 + ch);
                    float kk[4], kd[4]; float ss = 0.f, bon = 0.f;
#pragma unroll
                    for (int e = 0; e < 4; ++e) { kk[e] = kf[e] * kkw[ch + e]; ss += kk[e] * kk[e]; kd[e] = kf[e] * (1.f + (as[e] - 1.f) * kaw[ch + e]); bon += rf[e] * kd[e] * rkw[ch + e]; }
                    ss = red16(ss); bon = red16(bon);
                    const float rn = rsqrtf(fmaxf(ss, 1e-24f));
                    f32x4 okd, oa, ob, orr, ov;
#pragma unroll
                    for (int e = 0; e < 4; ++e) { const float kn = kk[e] * rn; okd[e] = kd[e]; oa[e] = -kn; ob[e] = kn * as[e]; orr[e] = rf[e]; ov[e] = vf[e]; }
                    *(LAS f32x4*)(st + 64 + ch) = okd; *(LAS f32x4*)(st + 128 + ch) = oa; *(LAS f32x4*)(st + 192 + ch) = ob; *(LAS f32x4*)(st + 256 + ch) = orr; *(LAS f32x4*)(st + 320 + ch) = ov;
                    if (fr == 0) SB[mr * 16 + head] = bon;
                }
            }
        } else {
            const int cp = c - 1;
            if (cp >= 0 && cp < NC) {
                const int r0 = (wave - 6) * 16; const LAS float* yb = ybuf + (cp & 1) * 2048;
#pragma unroll
                for (int i = 0; i < 4; ++i) { const int row = r0 + i * 4 + fq; const size_t mr = (size_t)b * T + tok_of(d, cp * 32 + row);
                    const f32x4 y4 = *(const LAS f32x4*)(yb + row * 64 + fr * 4); u32x2 w; w.x = pk2(y4[0], y4[1]); w.y = pk2(y4[2], y4[3]);
                    *(u32x2*)(Y + mr * D + head * 64 + fr * 4) = w; }
            }
        }
        __syncthreads();
    }
}

DI void rwkv_post_tile(int j, int item, LAS unsigned char* lds) {
    const int tile = item >> 2, ncq = item & 3;
    unsigned char* ws = WSP();
    const int tid = tid_opaque(), wave = __builtin_amdgcn_readfirstlane(tid >> 6), lane = tid & 63, fr = lane & 15, fq = lane >> 4;
    LAS bf16_t* As = (LAS bf16_t*)lds; LAS bf16_t* Bs = As + 128 * 200;
    const bf16_t* G1 = (const bf16_t*)(ws + OD_G1); const bf16_t* G2 = (const bf16_t*)(ws + W_G2_T) + (size_t)j * D * 192;
    const bf16_t* Y0 = (const bf16_t*)(ws + OD_Y); const bf16_t* Y1 = Y0 + (size_t)M * D;
    const bf16_t* Vb = (const bf16_t*)(ws + OD_RKV) + (size_t)2 * M * D; bf16_t* Yo = (bf16_t*)(ws + OD_RKV);
    const float* SB0 = (const float*)(ws + OD_SB); const float* SB1 = SB0 + (size_t)M * 16;
    const float* lng = IN(31) + j * D; const float* lnb = IN(32) + j * D;
    const int m0 = tile * 128;
    __syncthreads();
    for (int i = 0; i < 6; ++i) { const int idx = tid + 512 * i; const int row = idx / 24, ch = idx - row * 24;
        *(LAS u32x4*)(As + row * 200 + ch * 8) = *(const u32x4*)(G1 + (size_t)(m0 + row) * 256 + ch * 8); }
    const size_t m = (size_t)m0 + wave * 16 + fr;
    for (int nc = ncq * 2; nc < ncq * 2 + 2; ++nc) {
        __syncthreads();
        for (int i = 0; i < 6; ++i) { const int idx = tid + 512 * i; const int row = idx / 24, ch = idx - row * 24;
            *(LAS u32x4*)(Bs + row * 200 + ch * 8) = *(const u32x4*)(G2 + (size_t)(nc * 128 + row) * 192 + ch * 8); }
        __syncthreads();
        f32x4 acc[8];
#pragma unroll
        for (int i = 0; i < 8; ++i) acc[i] = (f32x4){0.f, 0.f, 0.f, 0.f};
        mm16<8, 6>(As + wave * 16 * 200, 200, Bs, 200, acc, fr, fq);
#pragma unroll
        for (int hh = 0; hh < 2; ++hh) {
            const int H = nc * 2 + hh; float y[4][4]; float sum = 0.f;
#pragma unroll
            for (int q = 0; q < 4; ++q) { const int c = nc * 128 + (hh * 4 + q) * 16 + fq * 4;
                const u32x2 a = *(const u32x2*)(Y0 + m * D + c), bq = *(const u32x2*)(Y1 + m * D + c);
                y[q][0] = bflo(a.x) + bflo(bq.x); y[q][1] = bfhi(a.x) + bfhi(bq.x); y[q][2] = bflo(a.y) + bflo(bq.y); y[q][3] = bfhi(a.y) + bfhi(bq.y);
                sum += y[q][0] + y[q][1] + y[q][2] + y[q][3]; }
            sum += __shfl_xor(sum, 16); sum += __shfl_xor(sum, 32);
            const float mean = sum * (1.f / 64.f); float vs = 0.f;
#pragma unroll
            for (int q = 0; q < 4; ++q)
#pragma unroll
                for (int e = 0; e < 4; ++e) { y[q][e] -= mean; vs += y[q][e] * y[q][e]; }
            vs += __shfl_xor(vs, 16); vs += __shfl_xor(vs, 32);
            const float rstd = rsqrtf(vs * (1.f / 64.f) + 64e-5f);
            const float sb = SB0[m * 16 + H] + SB1[m * 16 + H];
#pragma unroll
            for (int q = 0; q < 4; ++q) { const int c = nc * 128 + (hh * 4 + q) * 16 + fq * 4;
                const u32x2 vu = *(const u32x2*)(Vb + m * D + c); const float vf[4] = {bflo(vu.x), bfhi(vu.x), bflo(vu.y), bfhi(vu.y)};
                float o[4];
#pragma unroll
                for (int e = 0; e < 4; ++e) o[e] = (y[q][e] * rstd * lng[c + e] + lnb[c + e] + sb * vf[e]) * acc[hh * 4 + q][e];
                u32x2 w; w.x = pk2(o[0], o[1]); w.y = pk2(o[2], o[3]);
                *(u32x2*)(Yo + m * D + c) = w; }
        }
    }
    __syncthreads();
}


constexpr size_t WS_BAR = WS_TAB + 131072;
#define XB_TMO      128
#define XB_XCNT(j)  (256  + 64 * (j))
#define XB_XSUB(j)  (1280 + 64 * (j))
#define XB_XGEN(j)  (2304 + 64 * (j))
#define XB_TOP      3328
#define XB_TOPGEN   3392
#define XCD_BAR_WORDS 3456
#define XB_SPIN_CAP (1u << 20)
DI unsigned xb_ld(unsigned* p)              { return __hip_atomic_load(p, __ATOMIC_RELAXED, __HIP_MEMORY_SCOPE_AGENT); }
DI unsigned xb_add(unsigned* p, unsigned v) { return __hip_atomic_fetch_add(p, v, __ATOMIC_RELAXED, __HIP_MEMORY_SCOPE_AGENT); }
DI unsigned xb_xcc_id() { return (unsigned)__builtin_amdgcn_s_getreg((3 << 11) | 20) & 0xFu; }
#define XB_SPIN(cond, bar) do { unsigned _sp = 0; while (cond) { __builtin_amdgcn_s_sleep(1); \
    if ((++_sp & 255u) == 0u) { if (xb_ld(&(bar)[XB_TMO])) break; if (_sp > XB_SPIN_CAP) { atomicAdd(&(bar)[XB_TMO], 1u); break; } } } } while (0)
struct XcdBarrier { unsigned* bar; unsigned x; volatile LAS unsigned* st; };
DI XcdBarrier xcd_barrier_post(unsigned* bar, volatile LAS unsigned* st) {
    XcdBarrier b; b.bar = bar; b.x = xb_xcc_id(); b.st = st;
    if (threadIdx.x == 0) (void)xb_add(&bar[XB_XCNT(b.x)], 1u);
    return b;
}
DI void xcd_barrier_complete(unsigned* bar, unsigned x, unsigned& nloc, unsigned& nx) {
    const unsigned G = GDIM() * gridDim.y * gridDim.z;
    unsigned sum, cnt, mine, sp = 0u;
    for (;;) {
        sum = 0u; cnt = 0u; mine = 0u;
#pragma unroll
        for (unsigned j = 0; j < 16; ++j) { const unsigned c = xb_ld(&bar[XB_XCNT(j)]); sum += c; cnt += (c > 0u) ? 1u : 0u; mine = (j == x) ? c : mine; }
        if (sum == G) break;
        __builtin_amdgcn_s_sleep(1);
        if ((++sp & 255u) == 0u) { if (xb_ld(&bar[XB_TMO])) break; if (sp > XB_SPIN_CAP) { atomicAdd(&bar[XB_TMO], 1u); break; } }
    }
    nloc = mine > 0u ? mine : 1u; nx = cnt > 0u ? cnt : 1u;
}
DI void xcd_barrier(const XcdBarrier& b) {
    asm volatile("s_waitcnt vmcnt(0) lgkmcnt(0)" ::: "memory");
    __syncthreads();
    if (threadIdx.x == 0) {
        unsigned* bar = b.bar;
        __builtin_amdgcn_s_waitcnt(0);
        unsigned nloc = b.st[0], nx = b.st[1];
        if (nloc == 0u) { xcd_barrier_complete(bar, b.x, nloc, nx); b.st[0] = nloc; b.st[1] = nx; }
        const unsigned old = xb_add(&bar[XB_XSUB(b.x)], 1u);
        const unsigned gen = old / nloc;
        if (old + 1u == (gen + 1u) * nloc) {
            __builtin_amdgcn_fence(__ATOMIC_RELEASE, "agent");
            asm volatile("s_waitcnt vmcnt(0)" ::: "memory");
            const unsigned og = xb_add(&bar[XB_TOP], 1u);
            const unsigned tg = og / nx;
            if (og + 1u == (tg + 1u) * nx) xb_add(&bar[XB_TOPGEN], 1u);
            else XB_SPIN(xb_ld(&bar[XB_TOPGEN]) == tg, bar);
            __builtin_amdgcn_fence(__ATOMIC_ACQUIRE, "agent");
            xb_add(&bar[XB_XGEN(b.x)], 1u);
            asm volatile("s_waitcnt vmcnt(0)" ::: "memory");
        } else {
            XB_SPIN(xb_ld(&bar[XB_XGEN(b.x)]) == gen, bar);
            __builtin_amdgcn_fence(__ATOMIC_ACQUIRE, "agent");
            asm volatile("s_waitcnt vmcnt(0)" ::: "memory");
        }
    }
    __syncthreads();
}

DI void gsync(cg::grid_group& grid) {
    asm volatile("s_waitcnt vmcnt(0) lgkmcnt(0)" ::: "memory");
    grid.sync();
    asm volatile("" ::: "memory");
}
__global__ void __launch_bounds__(NTHREADS) fwd_megakernel(Params P) {
    extern __shared__ __attribute__((aligned(16))) unsigned char lds_raw[];
    LAS unsigned char* lds = (LAS unsigned char*)lds_raw;
    LAS unsigned char* ldsc = (LAS unsigned char*)16u;
    cg::grid_group grid = cg::this_grid();
    const int G = GDIM(), bid = BIDX();
    volatile LAS unsigned* xst = (volatile LAS unsigned*)(lds + 155136);
    if (threadIdx.x < 2) xst[threadIdx.x] = 0u;
    __syncthreads();
    const XcdBarrier xbar = xcd_barrier_post((unsigned*)(WSP() + WS_BAR), xst);

#pragma unroll 1
    for (int s = 0; s < 45; ++s) {
        int layer = 0, op = 0, q = 0;
        if (s > 0) { int r = s - 1;
            if (r < 8) layer = 0; else if (r < 22) { layer = 1; r -= 8; } else if (r < 30) { layer = 2; r -= 22; } else { layer = 3; r -= 30; }
            if ((layer & 1) == 0) op = r < 5 ? 1 + r : 11 + (r - 5);
            else { if (r < 8) { op = 6 + (r & 1); q = r >> 1; } else op = r < 11 ? 8 + (r - 8) : 11 + (r - 11); } }
        const int j = layer >> 1;
        const int bl = sgpr_opaque(bid), Gl = sgpr_opaque(G);
        LAS unsigned char* ldsl = lds; asm volatile("" : "+s"(ldsl));
        switch (op) {
        case 0: phase_setup(ldsl); break;
        case 1: phase_norm(layer, IN(6) + layer * D, 0, (bf16_t*)(WSP() + EV_H)); break;
        case 2: { unsigned char* ws = WSP(); pg8::StaticOrder S; S.init(M / 256, 12, Gl, bl);
              ADense af{(const bf16_t*)(ws + EV_H), D};
              EpiEvenIn E{(bf16_t*)(ws + EV_P), (float*)(ws + EV_G), IN(11) + j * 2832};
              pg8::gemm_phase(ldsl, af, (const bf16_t*)(ws + W_IN_T) + (size_t)j * 3072 * D, D, D, S, E); } break;
        case 3: for (int it = bl; it < 256; it += Gl) mlstm_item(j, it, ldsc);
                for (int it = bl; it < 544; it += Gl) attn_tile(j, it, ldsc); break;
        case 4: phase_ml_combine(j); break;
        case 5: { unsigned char* ws = WSP(); pg8::StaticOrder S; S.init(M / 256, 4, Gl, bl);
              ADense af{(const bf16_t*)(ws + EV_P), PW};
              EpiResid E{ws, OUTP(), layer, 2};
              pg8::gemm_phase(ldsl, af, (const bf16_t*)(ws + W_EVO_T) + (size_t)j * D * D, PW, D, S, E); } break;
        case 6: phase_rw_mix(layer, j, q, ldsc); break;
        case 7: { unsigned char* ws = WSP(); pg8::StaticOrder S; S.init(QROWS / 256, 15, Gl, bl);
              ARwkv af{(const bf16_t*)(ws + OD_XQ)};
              EpiRwkv E{(bf16_t*)(ws + OD_RKV), (bf16_t*)(ws + OD_L1), (bf16_t*)(ws + OD_G1), q * QROWS};
              pg8::gemm_phase(ldsl, af, (const bf16_t*)(ws + W_RKVL_T) + (size_t)j * 3840 * D, D, D, S, E); } break;
        case 8: for (int it = bl; it < 256; it += Gl) rwkv_scan_item(j, it, ldsc); break;
        case 9: for (int it = bl; it < (M / 128) * 4; it += Gl) rwkv_post_tile(j, it, ldsc); break;
        case 10: { unsigned char* ws = WSP(); pg8::StaticOrder S; S.init(M / 256, 4, Gl, bl);
              ADense af{(const bf16_t*)(ws + OD_RKV), D};
              EpiResid E{ws, OUTP(), layer, 2};
              pg8::gemm_phase(ldsl, af, (const bf16_t*)(ws + W_RWO_T) + (size_t)j * D * D, D, D, S, E); } break;
        case 11: phase_norm(layer, IN(7) + layer * D, 3, (bf16_t*)(WSP() + ML_H)); break;
        case 12: { unsigned char* ws = WSP(); pg8::StaticOrder S; S.init(M / 256, 16, Gl, bl, layer == 3);
              ADense af{(const bf16_t*)(ws + ML_H), D};
              EpiRelu2 E{(bf16_t*)(ws + ML_HID), FF};
              pg8::gemm_phase(ldsl, af, (const bf16_t*)(ws + W_M1_T) + (size_t)layer * FF * D, D, D, S, E); } break;
        default: { unsigned char* ws = WSP(); pg8::StaticOrder S; S.init(M / 256, 4, Gl, bl, layer == 3);
              ADense af{(const bf16_t*)(ws + ML_HID), FF};
              EpiResid E{ws, OUTP(), layer, 5};
              pg8::gemm_phase(ldsl, af, (const bf16_t*)(ws + W_M2_T) + (size_t)layer * D * FF, FF, FF, S, E); } break;
        }
        if (s == 0) gsync(grid);
        else if (s < 44) xcd_barrier(xbar);
    }
}

extern "C" void kernel_launch(void* const* d_in, const int* in_sizes, int n_in, void* d_out, int out_size, void* d_ws, size_t ws_size, hipStream_t stream) {
    static int grid_blocks = 0;
    if (grid_blocks == 0) {
        if (n_in != 34 || ws_size < WS_NEED) { fprintf(stderr, "kernel_launch: unexpected n_in %d / ws_size %zu (need %zu)\n", n_in, ws_size, (size_t)WS_NEED); grid_blocks = -1; return; }
        int dev = 0, cus = 0, per_cu = 0;
        hipGetDevice(&dev);
        hipDeviceGetAttribute(&cus, hipDeviceAttributeMultiprocessorCount, dev);
        if (hipFuncSetAttribute((const void*)fwd_megakernel, hipFuncAttributeMaxDynamicSharedMemorySize, LDS_BYTES) != hipSuccess) fprintf(stderr, "kernel_launch: hipFuncSetAttribute failed\n");
        hipOccupancyMaxActiveBlocksPerMultiprocessor(&per_cu, (const void*)fwd_megakernel, NTHREADS, LDS_BYTES);
        (void)hipGetLastError();
        if (per_cu < 1) per_cu = 1;
        grid_blocks = cus * 1;
    }
    if (grid_blocks < 0) return;
    if (hipMemsetAsync((char*)d_ws + WS_BAR, 0, XCD_BAR_WORDS * 4, stream) != hipSuccess) { fprintf(stderr, "kernel_launch: hipMemsetAsync of the barrier words failed\n"); return; }
    Params p{};
    for (int i = 0; i < 34; ++i) p.in[i] = (const float*)d_in[i];
    p.out = (float*)d_out; p.ws = (unsigned char*)d_ws;
    void* args[] = {&p};
    hipError_t e = hipLaunchCooperativeKernel((const void*)fwd_megakernel, dim3(grid_blocks), dim3(NTHREADS), args, LDS_BYTES, stream);
    if (e != hipSuccess) fprintf(stderr, "cooperative launch failed: %s (grid %d)\n", hipGetErrorString(e), grid_blocks);
}
```

```cpp
#include <hip/hip_runtime.h>
#include <hip/hip_cooperative_groups.h>
#include <cstdint>
#include <cstdio>
namespace cg = cooperative_groups;

#define LAS __attribute__((address_space(3)))
#define DI __device__ __forceinline__
typedef unsigned short bf16_t;
typedef short bf16x8 __attribute__((ext_vector_type(8)));
typedef float f32x4 __attribute__((ext_vector_type(4)));
typedef unsigned u32x4 __attribute__((ext_vector_type(4)));
typedef unsigned u32x2 __attribute__((ext_vector_type(2)));
typedef float f32x2 __attribute__((ext_vector_type(2)));

constexpr int NB = 8, LC = 256, SL = 4096, T = LC + SL, D = 1024, M = NB * T, FF = 4096;
constexpr int PW = 2816;
constexpr int QROWS = 2 * T;
constexpr int NTHREADS = 512;
constexpr int LDS_BYTES = 155648;
#ifndef PH
#define PH 0x7fff
#endif

constexpr size_t MiB = 1u << 20;
constexpr size_t WS_ZC = 0;
constexpr size_t WS_MOD = 8 * MiB;
constexpr size_t WS_TAB = 9 * MiB;
constexpr size_t WS_W = 10 * MiB;
constexpr size_t W_IN_T = WS_W;
constexpr size_t W_EVO_T = W_IN_T + 12 * MiB;
constexpr size_t W_M1_T = W_EVO_T + 4 * MiB;
constexpr size_t W_M2_T = W_M1_T + 32 * MiB;
constexpr size_t W_RKVL_T = W_M2_T + 32 * MiB;
constexpr size_t W_RWO_T = W_RKVL_T + 15 * MiB;
constexpr size_t W_2W_T = W_RWO_T + 4 * MiB;
constexpr size_t W_2A_T = W_2W_T + MiB / 2;
constexpr size_t W_G2_T = W_2A_T + MiB / 2;
constexpr size_t RA = 112 * MiB;
constexpr size_t EV_H = RA;
constexpr size_t EV_P = RA + 68 * MiB;
constexpr size_t EV_G = RA + 255 * MiB;
constexpr size_t EV_HB = RA + 258 * MiB;
constexpr size_t ML_H = RA;
constexpr size_t ML_HID = RA + 68 * MiB;
constexpr size_t OD_XQ = RA;
constexpr size_t OD_Y = RA;
constexpr size_t OD_RKV = RA + 136 * MiB;
constexpr size_t OD_L1 = RA + 340 * MiB;
constexpr size_t OD_G1 = RA + 357 * MiB;
constexpr size_t OD_SB = RA + 374 * MiB;
constexpr size_t WS_NEED = RA + 380 * MiB;

struct Params { const float* in[34]; float* out; unsigned char* ws; };
#define CAS __attribute__((address_space(4)))
__device__ __forceinline__ const void* kload(int off) {
    const CAS char* base = (const CAS char*)__builtin_amdgcn_kernarg_segment_ptr();
    asm volatile("" : "+s"(base));
    return *(const void* const CAS*)(base + off);
}
#define IN(k) ((const float*)kload(8 * (k)))
#define OUTP() ((float*)kload(272))
#define WSP() ((unsigned char*)kload(280))

DI unsigned f2bf(float f) { unsigned u = __builtin_bit_cast(unsigned, f); return (u + 0x7fffu + ((u >> 16) & 1u)) >> 16; }
DI unsigned pk2(float lo, float hi) { return f2bf(lo) | (f2bf(hi) << 16); }
DI float bflo(unsigned u) { return __builtin_bit_cast(float, u << 16); }
DI float bfhi(unsigned u) { return __builtin_bit_cast(float, u & 0xffff0000u); }
DI float bf1(bf16_t h) { return __builtin_bit_cast(float, ((unsigned)h) << 16); }
DI float sigmoidf_(float x) { return 1.f / (1.f + __expf(-x)); }
DI float tanhf_(float x) { float e = __expf(2.f * x); return 1.f - 2.f / (e + 1.f); }
DI float softcap_(float u) { return 15.f * tanhf_(u * (1.f / 15.f)); }
template <int CTRL> DI float dppmov(float x) { return __builtin_bit_cast(float, __builtin_amdgcn_update_dpp(0, __builtin_bit_cast(int, x), CTRL, 0xf, 0xf, true)); }
DI float red16(float x) { x += dppmov<0xB1>(x); x += dppmov<0x4E>(x); x += dppmov<0x141>(x); x += dppmov<0x140>(x); return x; }
DI float red8(float x) { x += dppmov<0xB1>(x); x += dppmov<0x4E>(x); x += dppmov<0x141>(x); return x; }
DI float red4(float x) { x += dppmov<0xB1>(x); x += dppmov<0x4E>(x); return x; }
DI int sgpr_opaque(int v) { asm volatile("" : "+s"(v)); return v; }
#define BIDX() sgpr_opaque((int)__builtin_amdgcn_workgroup_id_x())
#define GDIM() sgpr_opaque((int)__ockl_get_num_groups(0))
DI int tid_opaque() { int t = threadIdx.x; asm volatile("" : "+v"(t)); return t; }
DI float wave_sum(float v) {
#pragma unroll
    for (int o = 1; o < 64; o <<= 1) v += __shfl_xor(v, o);
    return v;
}
DI int tok_of(int d, int i) { if (i < LC) return d ? (LC - 1 - i) : i; return d ? (LC + SL - 1 - (i - LC)) : i; }
DI float* zrow(unsigned char* ws, float* out, int m) {
    const int b = m / T, t = m - b * T;
    return t < LC ? (float*)(ws + WS_ZC) + (size_t)(b * LC + t) * D : out + (size_t)(b * SL + t - LC) * D;
}
DI const float* zrow_src(const float* zc, const float* zl, int m) {
    const int b = m / T, t = m - b * T;
    return t < LC ? zc + (size_t)(b * LC + t) * D : zl + (size_t)(b * SL + t - LC) * D;
}
DI const float* modp(const unsigned char* ws, int layer, int who, int idx) { return (const float*)(ws + WS_MOD) + ((size_t)(layer * 9 + who) * 6 + idx) * D; }

template <int NT, int KS>
DI void mm16(const LAS bf16_t* A, int lda, const LAS bf16_t* B, int ldb, f32x4 (&acc)[NT], int fr, int fq) {
#pragma unroll
    for (int ks = 0; ks < KS; ++ks) {
        const bf16x8 a = *(const LAS bf16x8*)(A + fr * lda + ks * 32 + fq * 8);
#pragma unroll
        for (int nt = 0; nt < NT; ++nt) {
            const bf16x8 b = *(const LAS bf16x8*)(B + (nt * 16 + fr) * ldb + ks * 32 + fq * 8);
            acc[nt] = __builtin_amdgcn_mfma_f32_16x16x32_bf16(b, a, acc[nt], 0, 0, 0);
        }
    }
}

namespace pg8 {
constexpr int BM = 256, BK = 64, HALF = 128, HTB = HALF * BK * 2, NXCD = 8, WGM = 8;
__host__ __device__ __forceinline__ int lds_byte(int r, int c) { const int st = (r >> 4) * 2 + (c >> 5), rr = r & 15, cc = c & 31, ob = rr * 64 + cc * 2; return st * 1024 + (ob ^ (((ob >> 9) & 1) << 5)); }
__host__ __device__ __forceinline__ void stage_rc(int b, int& R, int& C) { const int st = b / 1024, sb = b % 1024, swz = sb ^ (((sb >> 9) & 1) << 5); R = (st >> 1) * 16 + swz / 64; C = (st & 1) * 32 + (swz % 64) / 2; }
__host__ __device__ __forceinline__ int perm32(int rho) { const int n = rho >> 4, i = rho & 15; return 8 * (i >> 2) + 4 * n + (i & 3); }
struct Unit { int pm, pn; };
struct StaticOrder {
    int nM, nN, nwg, G, c, skipctx;
    __device__ void init(int nM_, int nN_, int G_, int c_, int skipctx_ = 0) { skipctx = skipctx_; nM = skipctx_ ? nM_ / 17 * 16 : nM_; nN = nN_; nwg = nM * nN; G = G_; c = c_; }
    __device__ bool next(int i, Unit& u) const {
        const long L = (long)i * G + c; if (L >= nwg) return false;
        int wgid = (int)L; { const int q = nwg / NXCD, r = nwg % NXCD, xcd = wgid % NXCD, off = wgid / NXCD; wgid = (xcd < r ? xcd * (q + 1) : r * (q + 1) + (xcd - r) * q) + off; }
        const int nig = WGM * nN, gid = wgid / nig, fm = gid * WGM, gsz = (nM - fm) < WGM ? (nM - fm) : WGM;
        u.pm = fm + ((wgid % nig) % gsz); u.pn = (wgid % nig) / gsz; if (skipctx) u.pm = (u.pm >> 4) * 17 + 1 + (u.pm & 15); return true;
    }
};
DI unsigned cvt_pk_bf16(float lo, float hi) { unsigned r; asm volatile("v_cvt_pk_bf16_f32 %0, %1, %2" : "=v"(r) : "v"(lo), "v"(hi)); return r; }

template <class AF, class Epi>
DI void gemm_phase(LAS unsigned char* lds, const AF& af, const bf16_t* Bt, int lda, int K, const StaticOrder& S, const Epi& E) {
    const int tid = tid_opaque(), wid = __builtin_amdgcn_readfirstlane(tid >> 6), lane = tid & 63, wr = wid >> 2, wc = wid & 3, fr = lane & 15, fq = lane >> 4;
    const int nt = K / BK;
    unsigned voffA[2], voffB[2];
#pragma unroll
    for (int i = 0; i < 2; ++i) { int R, C; stage_rc(tid * 16 + i * 8192, R, C); const int Rb = (R & ~31) + perm32(R & 31);
        voffA[i] = (unsigned)(R * lda + C) * 2u; voffB[i] = (unsigned)(Rb * K + C) * 2u; }
    const size_t kstep = (size_t)(BK * 2);
    const size_t hstepA = (size_t)HALF * lda * 2, hstepB = (size_t)HALF * K * 2;
    const unsigned ldsw = (unsigned)wid * 1024u;
    const int aoff = lds_byte(wr * 64 + fr, fq * 8), boff = lds_byte(wc * 32 + fr, fq * 8);
#define PG8_SA(b, h) (((b) * 2 + (h)) * HTB)
#define PG8_SB(b, h) ((4 + (b) * 2 + (h)) * HTB)
#define PG8_STAGE(bufoff, gbase, voff) do { _Pragma("unroll") for (int _i = 0; _i < 2; ++_i) \
        __builtin_amdgcn_global_load_lds((const unsigned*)((const char*)(gbase) + (voff)[_i]), (LAS unsigned*)(lds + (bufoff) + ldsw + _i * 8192), 16, 0, 0); } while (0)
#define PG8_LDA(dst, b, h) do { _Pragma("unroll") for (int m = 0; m < 4; ++m) _Pragma("unroll") for (int k = 0; k < 2; ++k) dst[m][k] = *(const LAS bf16x8*)(lds + PG8_SA(b, h) + aoff + m * 2048 + k * 1024); } while (0)
#define PG8_LDB(dst, b, h) do { _Pragma("unroll") for (int n = 0; n < 2; ++n) _Pragma("unroll") for (int k = 0; k < 2; ++k) dst[n][k] = *(const LAS bf16x8*)(lds + PG8_SB(b, h) + boff + n * 2048 + k * 1024); } while (0)
#define PG8_MMA(ai, bj, At, Bt_) do { __builtin_amdgcn_s_setprio(1); _Pragma("unroll") for (int m = 0; m < 4; ++m) _Pragma("unroll") for (int n = 0; n < 2; ++n) _Pragma("unroll") for (int k = 0; k < 2; ++k) \
        acc[ai][bj][m][n] = __builtin_amdgcn_mfma_f32_16x16x32_bf16(Bt_[n][k], At[m][k], acc[ai][bj][m][n], 0, 0, 0); __builtin_amdgcn_s_setprio(0); } while (0)
#define PG8_WAIT_V(n) asm volatile("s_waitcnt vmcnt(" #n ")" ::: "memory")
#define PG8_WAIT_L(n) asm volatile("s_waitcnt lgkmcnt(" #n ")" ::: "memory")
#define PG8_BAR __builtin_amdgcn_s_barrier()
#define PG8_SCHED __builtin_amdgcn_sched_barrier(0)
    Unit cur, nxt; int ui = 0;
    if (!S.next(0, cur)) return;
    f32x4 acc[2][2][4][2];
#pragma unroll
    for (int a = 0; a < 2; ++a)
#pragma unroll
        for (int b = 0; b < 2; ++b)
#pragma unroll
            for (int m = 0; m < 4; ++m)
#pragma unroll
                for (int n = 0; n < 2; ++n) acc[a][b][m][n] = (f32x4){0.f, 0.f, 0.f, 0.f};
    bf16x8 At[4][2], B0[2][2], B1[2][2];
    const char* cA = af.a(cur.pm, cur.pn); const char* cB = (const char*)Bt + (size_t)cur.pn * 2 * hstepB;
    PG8_STAGE(PG8_SB(0, 0), cB, voffB); PG8_STAGE(PG8_SB(0, 1), cB + hstepB, voffB); PG8_STAGE(PG8_SA(0, 0), cA, voffA); PG8_STAGE(PG8_SA(0, 1), cA + hstepA, voffA);
    if (wr == 1) PG8_BAR;
    PG8_WAIT_V(2); PG8_BAR;
    PG8_STAGE(PG8_SB(1, 0), cB + kstep, voffB); PG8_STAGE(PG8_SA(1, 0), cA + kstep, voffA); PG8_STAGE(PG8_SB(1, 1), cB + hstepB + kstep, voffB);
    PG8_WAIT_V(6); PG8_BAR;
    for (;;) {
        const bool has_next = S.next(ui + 1, nxt);
        const char* nA = has_next ? af.a(nxt.pm, nxt.pn) : cA; const char* nB = has_next ? (const char*)Bt + (size_t)nxt.pn * 2 * hstepB : cB;
        for (int t = 0; t < nt; t += 2) {
            const bool last = (t == nt - 2);
            const char* a1 = cA + (size_t)(t + 1) * kstep;
            const char* a2 = last ? nA : cA + (size_t)(t + 2) * kstep; const char* b2 = last ? nB : cB + (size_t)(t + 2) * kstep;
            const char* a3 = a2 + kstep; const char* b3 = b2 + kstep;
            PG8_LDB(B0, 0, 0); PG8_LDB(B1, 0, 1); PG8_SCHED; PG8_LDA(At, 0, 0); PG8_STAGE(PG8_SA(1, 1), a1 + hstepA, voffA);
            PG8_WAIT_V(8); PG8_WAIT_L(0); PG8_BAR; PG8_MMA(0, 0, At, B0); PG8_MMA(0, 1, At, B1); PG8_BAR; PG8_SCHED;
            PG8_LDA(At, 0, 1); PG8_STAGE(PG8_SB(0, 0), b2, voffB); PG8_STAGE(PG8_SB(0, 1), b2 + hstepB, voffB); PG8_STAGE(PG8_SA(0, 0), a2, voffA);
            PG8_WAIT_V(8); PG8_WAIT_L(0); PG8_BAR; PG8_MMA(1, 0, At, B0); PG8_MMA(1, 1, At, B1); PG8_BAR; PG8_SCHED;
            PG8_LDB(B0, 1, 0); PG8_LDB(B1, 1, 1); PG8_SCHED; PG8_LDA(At, 1, 0); PG8_STAGE(PG8_SA(0, 1), a2 + hstepA, voffA);
            PG8_WAIT_V(8); PG8_WAIT_L(0); PG8_BAR; PG8_MMA(0, 0, At, B0); PG8_MMA(0, 1, At, B1); PG8_BAR; PG8_SCHED;
            PG8_LDA(At, 1, 1); PG8_STAGE(PG8_SB(1, 0), b3, voffB); PG8_STAGE(PG8_SB(1, 1), b3 + hstepB, voffB); PG8_STAGE(PG8_SA(1, 0), a3, voffA);
            PG8_WAIT_V(8); PG8_WAIT_L(0); PG8_BAR; PG8_MMA(1, 0, At, B0); PG8_MMA(1, 1, At, B1); PG8_BAR; PG8_SCHED;
        }
        if (wr == 0) PG8_BAR;
        E(acc, cur, wr, wc, fr, fq);
        if (!has_next) break;
#pragma unroll
        for (int a = 0; a < 2; ++a)
#pragma unroll
            for (int b = 0; b < 2; ++b)
#pragma unroll
                for (int m = 0; m < 4; ++m)
#pragma unroll
                    for (int n = 0; n < 2; ++n) acc[a][b][m][n] = (f32x4){0.f, 0.f, 0.f, 0.f};
        cur = nxt; cA = nA; cB = nB; ++ui;
        if (wr == 1) PG8_BAR;
    }
    PG8_WAIT_V(0);
    PG8_BAR;
#undef PG8_SA
#undef PG8_SB
#undef PG8_STAGE
#undef PG8_LDA
#undef PG8_LDB
#undef PG8_MMA
#undef PG8_WAIT_V
#undef PG8_WAIT_L
#undef PG8_BAR
#undef PG8_SCHED
}
}
using pg8::Unit;

struct ADense { const bf16_t* A; int lda; DI const char* a(int pm, int) const { return (const char*)(A + (size_t)pm * 256 * lda); } };
struct ARwkv { const bf16_t* X; DI const char* a(int pm, int pn) const {
        const int sel = pn < 4 ? 0 : pn < 8 ? 2 : pn < 12 ? 3 : pn == 12 ? 1 : pn == 13 ? 4 : 5;
        return (const char*)(X + (size_t)sel * QROWS * D + (size_t)pm * 256 * D); } };

DI int evmap(int n) {
    if (n < 512) return n; if (n < 1024) return 2064 + (n - 512); if (n < 1536) return 512 + (n - 1024); if (n < 2048) return 1024 + (n - 1536);
    if (n < 2560) return 1536 + (n - 2048); if (n < 2688) return 2576 + (n - 2560); if (n < 2816) return 2704 + (n - 2688); if (n < 2832) return 2048 + (n - 2816); return -1;
}
struct EpiEvenIn {
    bf16_t* Pb; float* G; const float* bias;
    DI void operator()(const f32x4 (&acc)[2][2][4][2], const Unit& u, int wr, int wc, int fr, int fq) const {
        const int row0 = u.pm * 256 + wr * 64 + fr;
#pragma unroll
        for (int bj = 0; bj < 2; ++bj) {
            const int col = u.pn * 256 + bj * 128 + wc * 32 + 8 * fq;
            const int oc = evmap(col);
            if (oc < 0) continue;
            const f32x4 b0 = *(const f32x4*)(bias + oc), b1 = *(const f32x4*)(bias + oc + 4);
#pragma unroll
            for (int ai = 0; ai < 2; ++ai)
#pragma unroll
                for (int m = 0; m < 4; ++m) {
                    const int row = row0 + ai * 128 + m * 16;
                    const f32x4 v0 = acc[ai][bj][m][0] + b0, v1 = acc[ai][bj][m][1] + b1;
                    if (col < 2816) { u32x4 w; w.x = pg8::cvt_pk_bf16(v0[0], v0[1]); w.y = pg8::cvt_pk_bf16(v0[2], v0[3]); w.z = pg8::cvt_pk_bf16(v1[0], v1[1]); w.w = pg8::cvt_pk_bf16(v1[2], v1[3]);
                        *(u32x4*)(Pb + (size_t)row * PW + col) = w; }
                    else { float* g = G + (size_t)row * 16 + (col - 2816); *(f32x4*)g = v0; *(f32x4*)(g + 4) = v1; }
                }
        }
    }
};
struct EpiRelu2 {
    bf16_t* O; int ldc;
    DI void operator()(const f32x4 (&acc)[2][2][4][2], const Unit& u, int wr, int wc, int fr, int fq) const {
        const int row0 = u.pm * 256 + wr * 64 + fr, col0 = u.pn * 256 + wc * 32 + 8 * fq;
#pragma unroll
        for (int ai = 0; ai < 2; ++ai)
#pragma unroll
            for (int m = 0; m < 4; ++m)
#pragma unroll
                for (int bj = 0; bj < 2; ++bj) {
                    f32x4 v0 = acc[ai][bj][m][0], v1 = acc[ai][bj][m][1];
#pragma unroll
                    for (int e = 0; e < 4; ++e) { float a = fmaxf(v0[e], 0.f); v0[e] = a * a; float b = fmaxf(v1[e], 0.f); v1[e] = b * b; }
                    u32x4 w; w.x = pg8::cvt_pk_bf16(v0[0], v0[1]); w.y = pg8::cvt_pk_bf16(v0[2], v0[3]); w.z = pg8::cvt_pk_bf16(v1[0], v1[1]); w.w = pg8::cvt_pk_bf16(v1[2], v1[3]);
                    *(u32x4*)(O + (size_t)(row0 + ai * 128 + m * 16) * ldc + col0 + bj * 128) = w;
                }
    }
};
struct EpiResid {
    unsigned char* ws; float* out; int layer, gidx; const float* zcs; const float* zls;
    DI void operator()(const f32x4 (&acc)[2][2][4][2], const Unit& u, int wr, int wc, int fr, int fq) const {
        const int b = u.pm / 17, jt = u.pm - b * 17;
        const int who = jt == 0 ? 8 : b;
        const float* gate = modp(ws, layer, who, gidx);
        float* zb = jt == 0 ? (float*)(ws + WS_ZC) + (size_t)(b * LC) * D : out + (size_t)(b * SL + (jt - 1) * 256) * D;
        const float* zs = jt == 0 ? zcs + (size_t)(b * LC) * D : zls + (size_t)(b * SL + (jt - 1) * 256) * D;
        const int r0 = wr * 64 + fr, col0 = u.pn * 256 + wc * 32 + 8 * fq;
#pragma unroll
        for (int ai = 0; ai < 2; ++ai)
#pragma unroll
            for (int m = 0; m < 4; ++m)
#pragma unroll
                for (int bj = 0; bj < 2; ++bj) {
                    const int col = col0 + bj * 128;
                    const f32x4 g0 = *(const f32x4*)(gate + col), g1 = *(const f32x4*)(gate + col + 4);
                    const size_t zo = (size_t)(r0 + ai * 128 + m * 16) * D + col; float* zp = zb + zo; const float* zq = zs + zo;
                    f32x4 z0 = *(const f32x4*)zq, z1 = *(const f32x4*)(zq + 4);
                    z0 += g0 * acc[ai][bj][m][0]; z1 += g1 * acc[ai][bj][m][1];
                    *(f32x4*)zp = z0; *(f32x4*)(zp + 4) = z1;
                    __builtin_amdgcn_sched_barrier(0);
                }
    }
};
struct EpiRwkv {
    bf16_t* RKV; bf16_t* L1; bf16_t* G1; int rowbase;
    DI void operator()(const f32x4 (&acc)[2][2][4][2], const Unit& u, int wr, int wc, int fr, int fq) const {
        const int row0 = rowbase + u.pm * 256 + wr * 64 + fr;
#pragma unroll
        for (int bj = 0; bj < 2; ++bj) {
            const int c = bj * 128 + wc * 32 + 8 * fq;
            if (u.pn >= 12 && u.pn < 14 && bj == 1) continue;
#pragma unroll
            for (int ai = 0; ai < 2; ++ai)
#pragma unroll
                for (int m = 0; m < 4; ++m) {
                    const int row = row0 + ai * 128 + m * 16;
                    f32x4 v0 = acc[ai][bj][m][0], v1 = acc[ai][bj][m][1];
                    bf16_t* dst;
                    if (u.pn < 12) dst = RKV + (size_t)(u.pn >> 2) * M * D + (size_t)row * D + (u.pn & 3) * 256 + c;
                    else if (u.pn == 12) {
#pragma unroll
                        for (int e = 0; e < 4; ++e) { v0[e] = tanhf_(v0[e]); v1[e] = tanhf_(v1[e]); }
                        dst = L1 + (size_t)row * 256 + c;
                    } else if (u.pn == 13) dst = L1 + (size_t)row * 256 + 128 + c;
                    else {
#pragma unroll
                        for (int e = 0; e < 4; ++e) { v0[e] = c < 160 ? sigmoidf_(v0[e]) : 0.f; v1[e] = c < 160 ? sigmoidf_(v1[e]) : 0.f; }
                        dst = G1 + (size_t)row * 256 + c;
                    }
                    u32x4 w; w.x = pg8::cvt_pk_bf16(v0[0], v0[1]); w.y = pg8::cvt_pk_bf16(v0[2], v0[3]); w.z = pg8::cvt_pk_bf16(v1[0], v1[1]); w.w = pg8::cvt_pk_bf16(v1[2], v1[3]);
                    *(u32x4*)dst = w;
                }
        }
    }
};

DI int colmap(int kind, int n) {
    if (kind == 0) return n;
    if (kind == 1) return evmap(n);
    if (kind == 2) return n < 128 ? (n >> 6) * 65536 + (n & 63) : -1;
    return n < 160 ? n : -1;
}
DI void transpose_tiles(const float* src, int ldw, int Ks, bf16_t* dst, int Nn, int Kd, int kind, LAS float* tile) {
    const int tid = tid_opaque(), ntn = Nn / 64, ntk = Kd / 64;
    for (int it = BIDX(); it < ntn * ntk; it += GDIM()) {
        const int n0 = (it % ntn) * 64, k0 = (it / ntn) * 64;
        { const int nn = tid & 63, kk = tid >> 6; const int off = colmap(kind, n0 + nn);
#pragma unroll
          for (int i = 0; i < 8; ++i) { const int k = k0 + kk + 8 * i; float v = 0.f; if (off >= 0 && k < Ks) v = src[(size_t)k * ldw + off]; tile[(kk + 8 * i) * 65 + nn] = v; } }
        __syncthreads();
        { const int nn = tid >> 3, kc = tid & 7; const LAS float* s = tile + (kc * 8) * 65 + nn;
          u32x4 o; o.x = pk2(s[0], s[65]); o.y = pk2(s[2 * 65], s[3 * 65]); o.z = pk2(s[4 * 65], s[5 * 65]); o.w = pk2(s[6 * 65], s[7 * 65]);
          *(u32x4*)(dst + (size_t)(n0 + nn) * Kd + k0 + kc * 8) = o; }
        __syncthreads();
    }
}
DI void phase_setup(LAS unsigned char* lds) {
    const int tid = tid_opaque(), G = GDIM(); unsigned char* ws = WSP();
    if (BIDX() == 0) { float* tab = (float*)(ws + WS_TAB);
        for (int e = tid; e < 1024; e += NTHREADS) { const int pos = e >> 4, i = e & 15;
            const float inv = exp2f(-(float)i * 0.83048202372184058696f);
            const float ang = (float)pos * inv; const float k = rintf(ang * 0.15915494309189533577f);
            float r = fmaf(-k, 6.28125f, ang); r = fmaf(-k, 1.9353071795864769e-3f, r);
            tab[e] = __cosf(r); tab[1024 + e] = __sinf(r); } }
    { LAS float* sv = (LAS float*)lds;
      LAS float* red = sv + 9 * 1024;
      { const float* cin = IN(1); const float* cctx = IN(3);
      for (int e = tid; e < 9 * 1024; e += NTHREADS) { const int who = e >> 10, k = e & 1023; const float c = who < 8 ? cin[who * D + k] : cctx[k]; sv[e] = c * sigmoidf_(c); } }
      const float* adaw = IN(4); const float* adab = IN(5);
      __syncthreads();
      for (int it = BIDX(); it < 4 * 48; it += G) {
          const int l = it / 48, n0 = (it % 48) * 128; const int kp = tid >> 7, nn = tid & 127;
          const float* w = adaw + (size_t)l * D * 6144 + n0 + nn;
          float a[9];
#pragma unroll
          for (int i = 0; i < 9; ++i) a[i] = 0.f;
          for (int k = kp * 256; k < kp * 256 + 256; ++k) { const float wv = w[(size_t)k * 6144];
#pragma unroll
              for (int i = 0; i < 9; ++i) a[i] = fmaf(sv[i * 1024 + k], wv, a[i]); }
#pragma unroll
          for (int i = 0; i < 9; ++i) red[(kp * 9 + i) * 128 + nn] = a[i];
          __syncthreads();
          if (kp == 0) { const float bias = adab[l * 6144 + n0 + nn];
#pragma unroll
              for (int i = 0; i < 9; ++i) { const float s = red[i * 128 + nn] + red[(9 + i) * 128 + nn] + red[(18 + i) * 128 + nn] + red[(27 + i) * 128 + nn];
                  ((float*)(ws + WS_MOD))[((size_t)(l * 9 + i)) * 6144 + n0 + nn] = s + bias; } }
          __syncthreads();
      } }
    LAS float* tile = (LAS float*)lds;
    for (int j = 0; j < 2; ++j) {
        transpose_tiles(IN(10) + (size_t)j * D * 2832, 2832, D, (bf16_t*)(ws + W_IN_T) + (size_t)j * 3072 * D, 3072, D, 1, tile);
        transpose_tiles(IN(12) + (size_t)j * D * D, D, D, (bf16_t*)(ws + W_EVO_T) + (size_t)j * D * D, D, D, 0, tile);
        for (int i = 0; i < 3; ++i) transpose_tiles(IN(19) + (size_t)(j * 3 + i) * D * D, D, D, (bf16_t*)(ws + W_RKVL_T) + (size_t)j * 3840 * D + (size_t)i * D * D, D, D, 0, tile);
        transpose_tiles(IN(21) + (size_t)j * 2 * D * 64, 64, D, (bf16_t*)(ws + W_RKVL_T) + (size_t)j * 3840 * D + (size_t)3072 * D, 256, D, 2, tile);
        transpose_tiles(IN(24) + (size_t)j * 2 * D * 64, 64, D, (bf16_t*)(ws + W_RKVL_T) + (size_t)j * 3840 * D + (size_t)3328 * D, 256, D, 2, tile);
        transpose_tiles(IN(26) + (size_t)j * D * 160, 160, D, (bf16_t*)(ws + W_RKVL_T) + (size_t)j * 3840 * D + (size_t)3584 * D, 256, D, 3, tile);
        for (int d = 0; d < 2; ++d) {
            transpose_tiles(IN(22) + (size_t)(j * 2 + d) * 64 * D, D, 64, (bf16_t*)(ws + W_2W_T) + (size_t)(j * 2 + d) * D * 64, D, 64, 0, tile);
            transpose_tiles(IN(25) + (size_t)(j * 2 + d) * 64 * D, D, 64, (bf16_t*)(ws + W_2A_T) + (size_t)(j * 2 + d) * D * 64, D, 64, 0, tile);
        }
        transpose_tiles(IN(27) + (size_t)j * 160 * D, D, 160, (bf16_t*)(ws + W_G2_T) + (size_t)j * D * 192, D, 192, 0, tile);
        transpose_tiles(IN(33) + (size_t)j * D * D, D, D, (bf16_t*)(ws + W_RWO_T) + (size_t)j * D * D, D, D, 0, tile);
    }
    for (int l = 0; l < 4; ++l) {
        transpose_tiles(IN(8) + (size_t)l * D * FF, FF, D, (bf16_t*)(ws + W_M1_T) + (size_t)l * FF * D, FF, D, 0, tile);
        transpose_tiles(IN(9) + (size_t)l * FF * D, D, FF, (bf16_t*)(ws + W_M2_T) + (size_t)l * D * FF, D, FF, 0, tile);
    }
}

DI void phase_norm(int layer, const float* g, int sidx, bf16_t* dst, bool first) {
    const int tid0 = tid_opaque(); const int lane = tid0 & 63, wave = tid0 >> 6; unsigned char* ws = WSP();
    const float* zcs = first ? IN(2) : (const float*)(ws + WS_ZC); const float* zls = first ? IN(0) : (const float*)OUTP();
    const int nw = GDIM() * 8;
    for (int m0 = BIDX() * 8 + wave; m0 < M; m0 += 2 * nw) {
        const int m1 = m0 + nw; const bool has1 = m1 < M; const int m1c = has1 ? m1 : m0;
        const float* z0 = zrow_src(zcs, zls, m0); const float* z1 = zrow_src(zcs, zls, m1c);
        f32x4 v0[4], v1[4]; float ss0 = 0.f, ss1 = 0.f;
#pragma unroll
        for (int j = 0; j < 4; ++j) { v0[j] = *(const f32x4*)(z0 + 4 * lane + 256 * j); v1[j] = *(const f32x4*)(z1 + 4 * lane + 256 * j); }
#pragma unroll
        for (int j = 0; j < 4; ++j) { ss0 += v0[j][0] * v0[j][0] + v0[j][1] * v0[j][1] + v0[j][2] * v0[j][2] + v0[j][3] * v0[j][3]; ss1 += v1[j][0] * v1[j][0] + v1[j][1] * v1[j][1] + v1[j][2] * v1[j][2] + v1[j][3] * v1[j][3]; }
#pragma unroll
        for (int o = 1; o < 64; o <<= 1) { ss0 += __shfl_xor(ss0, o); ss1 += __shfl_xor(ss1, o); }
#pragma unroll
        for (int r = 0; r < 2; ++r) {
            if (r == 1 && !has1) break;
            const int m = r ? m1 : m0; const int b = m / T, t = m - b * T; const int who = t < LC ? 8 : b;
            const float* sh = modp(ws, layer, who, sidx); const float* sc = modp(ws, layer, who, sidx + 1);
            const float rstd = rsqrtf((r ? ss1 : ss0) * (1.f / D) + 1e-6f);
#pragma unroll
            for (int j = 0; j < 4; ++j) { const int c = 4 * lane + 256 * j;
                const f32x4 gg = *(const f32x4*)(g + c), s1 = *(const f32x4*)(sc + c), s0 = *(const f32x4*)(sh + c);
                f32x4 y = (r ? v1[j] : v0[j]) * rstd * gg; y = y * (s1 + 1.f) + s0;
                u32x2 w; w.x = pk2(y[0], y[1]); w.y = pk2(y[2], y[3]);
                *(u32x2*)(dst + (size_t)m * D + c) = w; }
        }
    }
}

DI void mlstm_item(int j, int item, LAS unsigned char* lds) {
    unsigned char* ws = WSP();
    const int tid = tid_opaque(), wave = __builtin_amdgcn_readfirstlane(tid >> 6), lane = tid & 63, fr = lane & 15, fq = lane >> 4;
    const int b = item >> 5, head = (item >> 3) & 3, d = (item >> 2) & 1, vq = item & 3;
    LAS bf16_t* Qs = (LAS bf16_t*)lds; LAS bf16_t* KPs = Qs + 128 * 136; LAS bf16_t* KTs = KPs + 128 * 136;
    LAS bf16_t* VTs = KTs + 128 * 136; LAS bf16_t* VWs = VTs + 48 * 136; LAS bf16_t* Cs = VWs + 48 * 136;
    LAS float* lfs = (LAS float*)(Cs + 48 * 136); LAS float* ics = lfs + 128; LAS float* gs = ics + 128; LAS float* bcs = gs + 128;
    LAS float* wss = bcs + 128; LAS float* ats = wss + 128; LAS float* scal = ats + 128;
    const bf16_t* Pb = (const bf16_t*)(ws + EV_P); const float* Gt = (const float*)(ws + EV_G);
    bf16_t* HB = (bf16_t*)(ws + EV_HB) + (size_t)d * M * 512;
    const float fb = IN(13)[(j * 2 + d) * 4 + head];
    const float scale = 0.08838834764831845f;
    __syncthreads();
    for (int e = tid; e < 48 * 136; e += NTHREADS) { const int r = e / 136; Cs[e] = 0; VWs[e] = 0; VTs[e] = (r == 32) ? (bf16_t)0x3F80 : (bf16_t)0; }
    f32x4 Ct[3];
#pragma unroll
    for (int i = 0; i < 3; ++i) Ct[i] = (f32x4){0.f, 0.f, 0.f, 0.f};
    float mst = 0.f;
    const int prow_ = tid >> 2, pcs_ = tid & 3;
    float pgi = 0.f, pgf = 0.f; u32x4 pq[4], pk[4], pv;
    { if (tid < 128) { const int mr = b * T + tok_of(d, tid); pgi = Gt[(size_t)mr * 16 + d * 8 + head]; pgf = Gt[(size_t)mr * 16 + d * 8 + 4 + head]; }
      const bf16_t* s0_ = Pb + (size_t)(b * T + tok_of(d, prow_)) * PW + head * 128;
#pragma unroll
      for (int i = 0; i < 4; ++i) { pq[i] = *(const u32x4*)(s0_ + pcs_ * 32 + i * 8); pk[i] = *(const u32x4*)(s0_ + 1024 + pcs_ * 32 + i * 8); }
      pv = *(const u32x4*)(s0_ + 1536 + vq * 32 + pcs_ * 8); }
    for (int p = 0; p < 34; ++p) {
        const int i0 = p * 128;
        if (tid < 128) { ics[tid] = softcap_(pgi); const float x = softcap_(pgf + fb); lfs[tid] = -__logf(1.f + __expf(-x)); }
        __syncthreads();
        if (wave == 0) {
            const float a0 = lfs[2 * lane], a1 = lfs[2 * lane + 1]; const float c1 = a0 + a1;
            float x = c1;
#pragma unroll
            for (int o = 1; o < 64; o <<= 1) { const float y = __shfl_up(x, o); if (lane >= o) x += y; }
            const float ex = x - c1; const float bc0 = ex + a0, bc1 = ex + c1;
            const float g0 = ics[2 * lane] - bc0, g1 = ics[2 * lane + 1] - bc1;
            float pm = fmaxf(g0, g1);
#pragma unroll
            for (int o = 1; o < 64; o <<= 1) { const float y = __shfl_up(pm, o); if (lane >= o) pm = fmaxf(pm, y); }
            float pe = __shfl_up(pm, 1); if (lane == 0) pe = -3.0e38f;
            const float pm0 = fmaxf(pe, g0), pm1 = fmaxf(pe, fmaxf(g0, g1));
            const float bl = __shfl(x, 63), gmax = __shfl(pm, 63);
            const float mnew = fmaxf(bl + mst, bl + gmax);
            bcs[2 * lane] = bc0; bcs[2 * lane + 1] = bc1; gs[2 * lane] = g0; gs[2 * lane + 1] = g1;
            ats[2 * lane] = fmaxf(pm0, mst); ats[2 * lane + 1] = fmaxf(pm1, mst);
            wss[2 * lane] = __expf(bl + g0 - mnew) * scale; wss[2 * lane + 1] = __expf(bl + g1 - mnew) * scale;
            if (lane == 0) { scal[0] = mnew; scal[1] = __expf(bl + mst - mnew); }
        }
        __syncthreads();
        const float mnew = scal[0], carry = scal[1];
        {
            const int row = prow_, cs = pcs_;
#pragma unroll
            for (int i = 0; i < 4; ++i) { const u32x4 q = pq[i]; *(LAS u32x4*)(Qs + row * 136 + cs * 32 + i * 8) = q; }
#pragma unroll
            for (int i = 0; i < 4; ++i) { const u32x4 k = pk[i]; *(LAS u32x4*)(KPs + row * 136 + cs * 32 + i * 8) = k;
                const int c0 = cs * 32 + i * 8;
                KTs[(c0 + 0) * 136 + row] = (bf16_t)(k.x & 0xffff); KTs[(c0 + 1) * 136 + row] = (bf16_t)(k.x >> 16);
                KTs[(c0 + 2) * 136 + row] = (bf16_t)(k.y & 0xffff); KTs[(c0 + 3) * 136 + row] = (bf16_t)(k.y >> 16);
                KTs[(c0 + 4) * 136 + row] = (bf16_t)(k.z & 0xffff); KTs[(c0 + 5) * 136 + row] = (bf16_t)(k.z >> 16);
                KTs[(c0 + 6) * 136 + row] = (bf16_t)(k.w & 0xffff); KTs[(c0 + 7) * 136 + row] = (bf16_t)(k.w >> 16); }
            const u32x4 v = pv; const float ws = wss[row];
            const unsigned vv[4] = {v.x, v.y, v.z, v.w};
#pragma unroll
            for (int e = 0; e < 4; ++e) { const int c0 = cs * 8 + 2 * e;
                VTs[c0 * 136 + row] = (bf16_t)(vv[e] & 0xffff); VTs[(c0 + 1) * 136 + row] = (bf16_t)(vv[e] >> 16);
                VWs[c0 * 136 + row] = (bf16_t)f2bf(bflo(vv[e]) * ws); VWs[(c0 + 1) * 136 + row] = (bf16_t)f2bf(bfhi(vv[e]) * ws); }
            if (tid < 128) VWs[32 * 136 + tid] = (bf16_t)f2bf(wss[tid]);
            if (p + 1 < 34) {
                if (tid < 128) { const int mr = b * T + tok_of(d, i0 + 128 + tid); pgi = Gt[(size_t)mr * 16 + d * 8 + head]; pgf = Gt[(size_t)mr * 16 + d * 8 + 4 + head]; }
                const bf16_t* sn_ = Pb + (size_t)(b * T + tok_of(d, i0 + 128 + prow_)) * PW + head * 128;
#pragma unroll
                for (int i = 0; i < 4; ++i) { pq[i] = *(const u32x4*)(sn_ + pcs_ * 32 + i * 8); pk[i] = *(const u32x4*)(sn_ + 1024 + pcs_ * 32 + i * 8); }
                pv = *(const u32x4*)(sn_ + 1536 + vq * 32 + pcs_ * 8);
            }
        }
        __syncthreads();
        f32x4 s[8];
#pragma unroll
        for (int i = 0; i < 8; ++i) s[i] = (f32x4){0.f, 0.f, 0.f, 0.f};
        mm16<8, 4>(Qs + wave * 16 * 136, 136, KPs, 136, s, fr, fq);
        __syncthreads();
        const int trow = wave * 16 + fr; const float at = ats[trow];
#pragma unroll
        for (int nt = 0; nt < 8; ++nt) { const f32x4 g4 = *(const LAS f32x4*)(gs + nt * 16 + fq * 4); float o[4];
#pragma unroll
            for (int e = 0; e < 4; ++e) { const int sc = nt * 16 + fq * 4 + e; const float w = __expf(fminf(g4[e] - at, 0.f)); o[e] = (sc <= trow) ? s[nt][e] * scale * w : 0.f; }
            u32x2 w2; w2.x = pk2(o[0], o[1]); w2.y = pk2(o[2], o[3]);
            *(LAS u32x2*)(KPs + trow * 136 + nt * 16 + fq * 4) = w2; }
        __syncthreads();
        f32x4 num[3], num2[3];
#pragma unroll
        for (int i = 0; i < 3; ++i) { num[i] = (f32x4){0.f, 0.f, 0.f, 0.f}; num2[i] = (f32x4){0.f, 0.f, 0.f, 0.f}; }
        mm16<3, 4>(KPs + wave * 16 * 136, 136, VTs, 136, num, fr, fq);
        mm16<3, 4>(Qs + wave * 16 * 136, 136, Cs, 136, num2, fr, fq);
        {
            const float rs = __shfl(num[2][0], fr), qn = __shfl(num2[2][0], fr);
            const float iw = __expf(mst - at), mt = bcs[trow] + at;
            const float den = fmaxf(fabsf(rs + iw * qn), __expf(-mt)); const float inv = 1.f / den;
            const int mrow = b * T + tok_of(d, i0 + trow);
#pragma unroll
            for (int nt = 0; nt < 2; ++nt) { const f32x4 o = (num[nt] + num2[nt] * iw) * inv;
                u32x2 w2; w2.x = pk2(o[0], o[1]); w2.y = pk2(o[2], o[3]);
                *(u32x2*)(HB + (size_t)mrow * 512 + head * 128 + vq * 32 + nt * 16 + fq * 4) = w2; }
        }
#pragma unroll
        for (int i = 0; i < 3; ++i) Ct[i] *= carry;
        mm16<3, 4>(KTs + wave * 16 * 136, 136, VWs, 136, Ct, fr, fq);
        __syncthreads();
#pragma unroll
        for (int nt = 0; nt < 3; ++nt)
#pragma unroll
            for (int e = 0; e < 4; ++e) Cs[(nt * 16 + fq * 4 + e) * 136 + wave * 16 + fr] = (bf16_t)f2bf(Ct[nt][e]);
        mst = mnew;
    }
    __syncthreads();
}

DI void attn_load_head(const bf16_t* Pb, int coloff, int b, int t0, const float* g, bool rope, float scale, const float* tab, LAS bf16_t* dst) {
    const int tid = tid_opaque(), row = tid >> 2, q4 = tid & 3; const int t = t0 + row; const size_t mrow = (size_t)b * T + t;
    const bf16_t* src = Pb + mrow * PW + coloff;
    float y[4][4]; float ss = 0.f;
#pragma unroll
    for (int c = 0; c < 4; ++c) { const u32x2 u = *(const u32x2*)(src + c * 16 + q4 * 4); y[c][0] = bflo(u.x); y[c][1] = bfhi(u.x); y[c][2] = bflo(u.y); y[c][3] = bfhi(u.y);
#pragma unroll
        for (int e = 0; e < 4; ++e) ss += y[c][e] * y[c][e]; }
    ss = red4(ss); const float rstd = rsqrtf(ss * (1.f / 64.f) + 1e-6f);
#pragma unroll
    for (int c = 0; c < 4; ++c)
#pragma unroll
        for (int e = 0; e < 4; ++e) y[c][e] = y[c][e] * rstd * g[c * 16 + q4 * 4 + e];
    if (rope) { const int pos = t - LC, rp = pos >> 6, cp = pos & 63;
#pragma unroll
        for (int e = 0; e < 4; ++e) { const int i = q4 * 4 + e;
            { const float co = tab[rp * 16 + i], si = tab[1024 + rp * 16 + i]; const float x1 = y[0][e], x2 = y[1][e]; y[0][e] = x1 * co - x2 * si; y[1][e] = x1 * si + x2 * co; }
            { const float co = tab[cp * 16 + i], si = tab[1024 + cp * 16 + i]; const float x1 = y[2][e], x2 = y[3][e]; y[2][e] = x1 * co - x2 * si; y[3][e] = x1 * si + x2 * co; } } }
#pragma unroll
    for (int c = 0; c < 4; ++c) { u32x2 w; w.x = pk2(y[c][0] * scale, y[c][1] * scale); w.y = pk2(y[c][2] * scale, y[c][3] * scale);
        *(LAS u32x2*)(dst + row * 72 + c * 16 + q4 * 4) = w; }
}
DI void attn_tile(int j, int tile, LAS unsigned char* lds) {
    unsigned char* ws = WSP();
    const int tid = tid_opaque(), wave = __builtin_amdgcn_readfirstlane(tid >> 6), lane = tid & 63, fr = lane & 15, fq = lane >> 4;
    int b, kvh, qb; bool lat;
    if (tile < 512) { lat = true; b = tile >> 6; kvh = (tile >> 5) & 1; qb = tile & 31; } else { const int c = tile - 512; lat = false; b = c >> 2; kvh = (c >> 1) & 1; qb = c & 1; }
    LAS bf16_t* Qs = (LAS bf16_t*)lds; LAS bf16_t* Ks = Qs + 4 * 128 * 72; LAS bf16_t* VTs = Ks + 128 * 72; LAS bf16_t* Ps = VTs + 64 * 136;
    bf16_t* Pb = (bf16_t*)(ws + EV_P); const float* tab = (const float*)(ws + WS_TAB);
    const float* qg = IN(15) + j * 64; const float* kg = IN(16) + j * 64; const float* sinkp = IN(17) + j * 8 + kvh * 4;
    const int tq0 = lat ? LC + qb * 128 : qb * 128;
    __syncthreads();
    for (int g = 0; g < 4; ++g) attn_load_head(Pb, 512 + (kvh * 4 + g) * 64, b, tq0, qg, lat, 0.125f, tab, Qs + g * 128 * 72);
    f32x4 O[4][4]; float mr[4], lr[4];
#pragma unroll
    for (int g = 0; g < 4; ++g) { mr[g] = sinkp[g]; lr[g] = 1.f;
#pragma unroll
        for (int i = 0; i < 4; ++i) O[g][i] = (f32x4){0.f, 0.f, 0.f, 0.f}; }
    const int nkb = lat ? 5 : 2;
    for (int kb = 0; kb < nkb; ++kb) {
        int tk0; int mask = 0; bool krope = false;
        if (kb < 2) tk0 = kb * 128;
        else { const int kq = qb + (kb - 3); if (kq < 0 || kq > 31) continue; tk0 = LC + kq * 128; krope = true; mask = kb == 2 ? 1 : (kb == 4 ? 2 : 0); }
        __syncthreads();
        attn_load_head(Pb, 2560 + kvh * 64, b, tk0, kg, krope, 1.f, tab, Ks);
        { const int row = tid >> 2, q4 = tid & 3; const bf16_t* src = Pb + ((size_t)b * T + tk0 + row) * PW + 2688 + kvh * 64 + q4 * 16;
          const u32x4 v0 = *(const u32x4*)src, v1 = *(const u32x4*)(src + 8); const unsigned vv[8] = {v0.x, v0.y, v0.z, v0.w, v1.x, v1.y, v1.z, v1.w};
#pragma unroll
          for (int e = 0; e < 8; ++e) { VTs[(q4 * 16 + 2 * e) * 136 + row] = (bf16_t)(vv[e] & 0xffff); VTs[(q4 * 16 + 2 * e + 1) * 136 + row] = (bf16_t)(vv[e] >> 16); } }
        __syncthreads();
        const float sgnf = mask == 1 ? 1.f : (mask == 2 ? -1.f : 0.f);
        const float basef = (float)(fq * 4 - (wave * 16 + fr)) * sgnf;
#pragma unroll
        for (int g = 0; g < 4; ++g) {
            asm volatile("" ::: "memory");
            f32x4 s[8];
#pragma unroll
            for (int i = 0; i < 8; ++i) s[i] = (f32x4){0.f, 0.f, 0.f, 0.f};
            mm16<8, 2>(Qs + g * 128 * 72 + wave * 16 * 72, 72, Ks, 72, s, fr, fq);
            const int qi = wave * 16 + fr;
            float mx = -3.0e38f;
#pragma unroll
            for (int nt = 0; nt < 8; ++nt)
#pragma unroll
                for (int e = 0; e < 4; ++e) { const float tf = fmaf(sgnf, (float)(nt * 16 + e), basef);
                    s[nt][e] += fminf(tf, 0.f) * 1.0e30f; mx = fmaxf(mx, s[nt][e]); }
            mx = fmaxf(mx, __shfl_xor(mx, 16)); mx = fmaxf(mx, __shfl_xor(mx, 32));
            const float mn = fmaxf(mr[g], mx); const float alpha = __expf(mr[g] - mn);
            float rs = 0.f;
#pragma unroll
            for (int nt = 0; nt < 8; ++nt) { float o[4];
#pragma unroll
                for (int e = 0; e < 4; ++e) { o[e] = __expf(s[nt][e] - mn); rs += o[e]; }
                u32x2 w2; w2.x = pk2(o[0], o[1]); w2.y = pk2(o[2], o[3]);
                *(LAS u32x2*)(Ps + qi * 136 + nt * 16 + fq * 4) = w2; }
            rs += __shfl_xor(rs, 16); rs += __shfl_xor(rs, 32);
            lr[g] = lr[g] * alpha + rs; mr[g] = mn;
#pragma unroll
            for (int i = 0; i < 4; ++i) O[g][i] *= alpha;
            mm16<4, 4>(Ps + wave * 16 * 136, 136, VTs, 136, O[g], fr, fq);
        }
    }
    { const size_t mrow = (size_t)b * T + tq0 + wave * 16 + fr;
#pragma unroll
      for (int g = 0; g < 4; ++g) { const float inv = 1.f / lr[g];
#pragma unroll
          for (int nt = 0; nt < 4; ++nt) { const f32x4 o = O[g][nt] * inv; u32x2 w2; w2.x = pk2(o[0], o[1]); w2.y = pk2(o[2], o[3]);
              *(u32x2*)(Pb + mrow * PW + 512 + (kvh * 4 + g) * 64 + nt * 16 + fq * 4) = w2; } } }
    __syncthreads();
}

DI void phase_ml_combine(int j) {
    const int tid0 = tid_opaque(); const int lane = tid0 & 63, wave = tid0 >> 6; unsigned char* ws = WSP();
    bf16_t* Pb = (bf16_t*)(ws + EV_P); const bf16_t* H0 = (const bf16_t*)(ws + EV_HB); const bf16_t* H1 = H0 + (size_t)M * 512;
    const float* og = IN(14) + j * 512;
    for (int m = BIDX() * 8 + wave; m < M; m += GDIM() * 8) {
        const int col = lane * 8;
        const u32x4 a = *(const u32x4*)(H0 + (size_t)m * 512 + col), c = *(const u32x4*)(H1 + (size_t)m * 512 + col), o = *(const u32x4*)(Pb + (size_t)m * PW + 2048 + col);
        const unsigned av[4] = {a.x, a.y, a.z, a.w}, cv[4] = {c.x, c.y, c.z, c.w}, ov[4] = {o.x, o.y, o.z, o.w};
        float s[8]; float ss = 0.f;
#pragma unroll
        for (int e = 0; e < 4; ++e) { s[2 * e] = bflo(av[e]) + bflo(cv[e]); s[2 * e + 1] = bfhi(av[e]) + bfhi(cv[e]); ss += s[2 * e] * s[2 * e] + s[2 * e + 1] * s[2 * e + 1]; }
        ss = red16(ss); const float rstd = rsqrtf(ss * (1.f / 128.f) + 1e-6f);
        unsigned w[4];
#pragma unroll
        for (int e = 0; e < 4; ++e) { const float y0 = s[2 * e] * rstd * og[col + 2 * e] * sigmoidf_(bflo(ov[e])); const float y1 = s[2 * e + 1] * rstd * og[col + 2 * e + 1] * sigmoidf_(bfhi(ov[e])); w[e] = pk2(y0, y1); }
        u32x4 wv; wv.x = w[0]; wv.y = w[1]; wv.z = w[2]; wv.w = w[3];
        *(u32x4*)(Pb + (size_t)m * PW + col) = wv;
    }
}

DI void phase_rw_mix(int layer, int j, int q, LAS unsigned char* lds) {
    const int tid = tid_opaque(), lane = tid & 63, wave = tid >> 6; unsigned char* ws = WSP(); float* outp = OUTP();
    LAS float* hs = (LAS float*)lds;
    const float* g = IN(6) + layer * D; const float* mu = IN(18) + (size_t)j * 12 * D;
    bf16_t* X = (bf16_t*)(ws + OD_XQ);
    for (int it = BIDX(); it < QROWS / 17; it += GDIM()) {
        const int lr0 = it * 17, m0 = q * QROWS + lr0; const int b = m0 / T, t0 = m0 - b * T;
        __syncthreads();
        for (int rr = wave; rr < 19; rr += 8) {
            const int t = t0 - 1 + rr;
            if (t < 0 || t >= T) {
#pragma unroll
                for (int jj = 0; jj < 4; ++jj) *(LAS f32x4*)(hs + rr * 1024 + 4 * lane + 256 * jj) = (f32x4){0.f, 0.f, 0.f, 0.f};
            } else {
                const int who = t < LC ? 8 : b; const float* sh = modp(ws, layer, who, 0); const float* sc = modp(ws, layer, who, 1);
                const float* z = zrow(ws, outp, b * T + t); f32x4 v[4]; float ss = 0.f;
#pragma unroll
                for (int jj = 0; jj < 4; ++jj) { v[jj] = *(const f32x4*)(z + 4 * lane + 256 * jj); ss += v[jj][0] * v[jj][0] + v[jj][1] * v[jj][1] + v[jj][2] * v[jj][2] + v[jj][3] * v[jj][3]; }
                const float rstd = rsqrtf(wave_sum(ss) * (1.f / D) + 1e-6f);
#pragma unroll
                for (int jj = 0; jj < 4; ++jj) { const int c = 4 * lane + 256 * jj;
                    const f32x4 gg = *(const f32x4*)(g + c), a1 = *(const f32x4*)(sc + c), a0 = *(const f32x4*)(sh + c);
                    f32x4 y = v[jj] * rstd * gg; y = y * (a1 + 1.f) + a0; *(LAS f32x4*)(hs + rr * 1024 + c) = y; }
            }
        }
        __syncthreads();
        const int c4 = tid & 255, rh = tid >> 8;
        f32x4 mu0[6], mu1[6];
#pragma unroll
        for (int i = 0; i < 6; ++i) { mu0[i] = *(const f32x4*)(mu + (size_t)(i * 2) * D + 4 * c4); mu1[i] = *(const f32x4*)(mu + (size_t)(i * 2 + 1) * D + 4 * c4); }
        for (int k = 0; k < 9; ++k) { const int r = rh + 2 * k; if (r >= 17) break;
            const int t = t0 + r;
            const f32x4 u = *(const LAS f32x4*)(hs + (r + 1) * 1024 + 4 * c4);
            f32x4 pv = *(const LAS f32x4*)(hs + r * 1024 + 4 * c4), nx = *(const LAS f32x4*)(hs + (r + 2) * 1024 + 4 * c4);
            if (t == 0 || t == LC) pv = (f32x4){0.f, 0.f, 0.f, 0.f};
            if (t == LC - 1 || t == T - 1) nx = (f32x4){0.f, 0.f, 0.f, 0.f};
            const f32x4 dp = pv - u, dn = nx - u;
#pragma unroll
            for (int i = 0; i < 6; ++i) { const f32x4 x = u + mu0[i] * dp + mu1[i] * dn; u32x2 w; w.x = pk2(x[0], x[1]); w.y = pk2(x[2], x[3]);
                *(u32x2*)(X + (size_t)i * QROWS * D + (size_t)(lr0 + r) * D + 4 * c4) = w; } }
    }
    __syncthreads();
}

DI void rwkv_scan_item(int j, int item, LAS unsigned char* lds) {
    unsigned char* ws = WSP();
    const int tid = tid_opaque(), wave = __builtin_amdgcn_readfirstlane(tid >> 6), lane = tid & 63, fr = lane & 15, fq = lane >> 4;
    const int b = item >> 5, head = (item >> 1) & 15, d = item & 1;
    LAS float* steps = (LAS float*)lds;
    LAS bf16_t* L1w = (LAS bf16_t*)(lds + 98304);
    LAS bf16_t* W2w = (LAS bf16_t*)(lds + 107008);
    LAS bf16_t* W2a = (LAS bf16_t*)(lds + 116224);
    LAS float* ybuf = (LAS float*)(lds + 125440);
    const bf16_t* R = (const bf16_t*)(ws + OD_RKV); const bf16_t* Kb = R + (size_t)M * D; const bf16_t* Vb = Kb + (size_t)M * D;
    const bf16_t* L1 = (const bf16_t*)(ws + OD_L1);
    bf16_t* Y = (bf16_t*)(ws + OD_Y) + (size_t)d * M * D; float* SB = (float*)(ws + OD_SB) + (size_t)d * M * 16;
    constexpr int NC = T / 32;
    __syncthreads();
    { const int n = tid >> 3, kc = tid & 7;
      const bf16_t* sw = (const bf16_t*)(ws + W_2W_T) + ((size_t)(j * 2 + d) * D + head * 64 + n) * 64 + kc * 8;
      const bf16_t* sa = (const bf16_t*)(ws + W_2A_T) + ((size_t)(j * 2 + d) * D + head * 64 + n) * 64 + kc * 8;
      *(LAS u32x4*)(W2w + n * 72 + kc * 8) = *(const u32x4*)sw; *(LAS u32x4*)(W2a + n * 72 + kc * 8) = *(const u32x4*)sa; }
    __syncthreads();
    const int rp = (tid >> 3) & 31, cg8 = tid & 7;
    f32x4 s0a = (f32x4){0.f, 0.f, 0.f, 0.f}, s0b = s0a, s1a = s0a, s1b = s0a;
    for (int c = -1; c <= NC; ++c) {
        if (wave < 4) {
            if (c >= 0 && c < NC) {
                const LAS float* sbuf = steps + (c & 1) * 12288; LAS float* yb = ybuf + (c & 1) * 2048;
#pragma unroll 4
                for (int t = 0; t < 32; ++t) {
                    const LAS float* st = sbuf + t * 384 + cg8 * 8;
                    const f32x4 w4a = *(const LAS f32x4*)(st), w4b = *(const LAS f32x4*)(st + 4), k4a = *(const LAS f32x4*)(st + 64), k4b = *(const LAS f32x4*)(st + 68),
                                a4a = *(const LAS f32x4*)(st + 128), a4b = *(const LAS f32x4*)(st + 132), b4a = *(const LAS f32x4*)(st + 192), b4b = *(const LAS f32x4*)(st + 196),
                                r4a = *(const LAS f32x4*)(st + 256), r4b = *(const LAS f32x4*)(st + 260);
                    const float v0 = sbuf[t * 384 + 320 + rp], v1 = sbuf[t * 384 + 320 + rp + 32];
                    f32x4 p0 = s0a * a4a + s0b * a4b, p1 = s1a * a4a + s1b * a4b;
                    const f32x2 qa0 = p0.xy + p0.zw, qa1 = p1.xy + p1.zw;
                    float sa0 = qa0.x + qa0.y, sa1 = qa1.x + qa1.y;
                    sa0 = red8(sa0); sa1 = red8(sa1);
                    s0a = s0a * w4a + b4a * sa0 + k4a * v0; s0b = s0b * w4b + b4b * sa0 + k4b * v0;
                    s1a = s1a * w4a + b4a * sa1 + k4a * v1; s1b = s1b * w4b + b4b * sa1 + k4b * v1;
                    p0 = s0a * r4a + s0b * r4b; p1 = s1a * r4a + s1b * r4b;
                    const f32x2 qy0 = p0.xy + p0.zw, qy1 = p1.xy + p1.zw;
                    float y0 = qy0.x + qy0.y, y1 = qy1.x + qy1.y;
                    y0 = red8(y0); y1 = red8(y1);
                    if (cg8 == 0) { yb[t * 64 + rp] = y0; yb[t * 64 + rp + 32] = y1; }
                }
            }
        } else if (wave < 6) {
            const int cn = c + 1;
            if (cn < NC) {
                const int pw = wave - 4, r0 = pw * 16, i0 = cn * 32;
                LAS float* sbuf = steps + (cn & 1) * 12288; LAS bf16_t* Lw = L1w + pw * 16 * 136;
                u32x4 l1v[4]; u32x2 kv[4], rv[4], vv[4];
#pragma unroll
                for (int i = 0; i < 4; ++i) { const int q = lane + 64 * i; const int row = q >> 4, cc = q & 15; const int sc = cc < 8 ? d * 64 + cc * 8 : 128 + d * 64 + (cc - 8) * 8;
                    const size_t mr = (size_t)b * T + tok_of(d, i0 + r0 + row);
                    l1v[i] = *(const u32x4*)(L1 + mr * 256 + sc); }
#pragma unroll
                for (int i = 0; i < 4; ++i) { const int row = i * 4 + fq; const size_t mr = (size_t)b * T + tok_of(d, i0 + r0 + row);
                    kv[i] = *(const u32x2*)(Kb + mr * D + head * 64 + fr * 4); rv[i] = *(const u32x2*)(R + mr * D + head * 64 + fr * 4); vv[i] = *(const u32x2*)(Vb + mr * D + head * 64 + fr * 4); }
#pragma unroll
                for (int i = 0; i < 4; ++i) { const int q = lane + 64 * i; *(LAS u32x4*)(Lw + (q >> 4) * 136 + (q & 15) * 8) = l1v[i]; }
                asm volatile("s_waitcnt lgkmcnt(0)" ::: "memory");
                const float* w0 = IN(20) + (size_t)(j * 2 + d) * D + head * 64; const float* a0 = IN(23) + (size_t)(j * 2 + d) * D + head * 64;
                { f32x4 acc[4];
#pragma unroll
                  for (int i = 0; i < 4; ++i) acc[i] = (f32x4){0.f, 0.f, 0.f, 0.f};
                  mm16<4, 2>(Lw, 136, W2w, 72, acc, fr, fq);
#pragma unroll
                  for (int nt = 0; nt < 4; ++nt) { const int ch = nt * 16 + fq * 4; f32x4 o;
#pragma unroll
                      for (int e = 0; e < 4; ++e) { const float wp = w0[ch + e] + acc[nt][e]; const float wl = -__logf(1.f + __expf(-wp)) - 0.5f; o[e] = __expf(-__expf(wl)); }
                      *(LAS f32x4*)(sbuf + (r0 + fr) * 384 + ch) = o; } }
                { f32x4 acc[4];
#pragma unroll
                  for (int i = 0; i < 4; ++i) acc[i] = (f32x4){0.f, 0.f, 0.f, 0.f};
                  mm16<4, 2>(Lw + 64, 136, W2a, 72, acc, fr, fq);
#pragma unroll
                  for (int nt = 0; nt < 4; ++nt) { const int ch = nt * 16 + fq * 4; f32x4 o;
#pragma unroll
                      for (int e = 0; e < 4; ++e) o[e] = sigmoidf_(a0[ch + e] + acc[nt][e]);
                      *(LAS f32x4*)(sbuf + (r0 + fr) * 384 + 128 + ch) = o; } }
                asm volatile("s_waitcnt lgkmcnt(0)" ::: "memory");
                const float* kkw = IN(28) + j * D + head * 64; const float* kaw = IN(29) + j * D + head * 64; const float* rkw = IN(30) + (j * 16 + head) * 64;
#pragma unroll
                for (int i = 0; i < 4; ++i) {
                    const int row = r0 + i * 4 + fq, ch = fr * 4; const size_t mr = (size_t)b * T + tok_of(d, i0 + row);
                    const u32x2 ku = kv[i], ru = rv[i], vu = vv[i];
                    const float kf[4] = {bflo(ku.x), bfhi(ku.x), bflo(ku.y), bfhi(ku.y)}, rf[4] = {bflo(ru.x), bfhi(ru.x), bflo(ru.y), bfhi(ru.y)}, vf[4] = {bflo(vu.x), bfhi(vu.x), bflo(vu.y), bfhi(vu.y)};
                    LAS float* st = sbuf + row * 384;
                    const f32x4 as = *(const LAS f32x4*)(st + 128 + ch);
                    float kk[4], kd[4]; float ss = 0.f, bon = 0.f;
#pragma unroll
                    for (int e = 0; e < 4; ++e) { kk[e] = kf[e] * kkw[ch + e]; ss += kk[e] * kk[e]; kd[e] = kf[e] * (1.f + (as[e] - 1.f) * kaw[ch + e]); bon += rf[e] * kd[e] * rkw[ch + e]; }
                    ss = red16(ss); bon = red16(bon);
                    const float rn = rsqrtf(fmaxf(ss, 1e-24f));
                    f32x4 okd, oa, ob, orr, ov;
#pragma unroll
                    for (int e = 0; e < 4; ++e) { const float kn = kk[e] * rn; okd[e] = kd[e]; oa[e] = -kn; ob[e] = kn * as[e]; orr[e] = rf[e]; ov[e] = vf[e]; }
                    *(LAS f32x4*)(st + 64 + ch) = okd; *(LAS f32x4*)(st + 128 + ch) = oa; *(LAS f32x4*)(st + 192 + ch) = ob; *(LAS f32x4*)(st + 256 + ch) = orr; *(LAS f32x4*)(st + 320 + ch) = ov;
                    if (fr == 0) SB[mr * 16 + head] = bon;
                }
            }
        } else {
            const int cp = c - 1;
            if (cp >= 0 && cp < NC) {
                const int r0 = (wave - 6) * 16; const LAS float* yb = ybuf + (cp & 1) * 2048;
#pragma unroll
                for (int i = 0; i < 4; ++i) { const int row = r0 + i * 4 + fq; const size_t mr = (size_t)b * T + tok_of(d, cp * 32 + row);
                    const f32x4 y4 = *(const LAS f32x4*)(yb + row * 64 + fr * 4); u32x2 w; w.x = pk2(y4[0], y4[1]); w.y = pk2(y4[2], y4[3]);
                    *(u32x2*)(Y + mr * D + head * 64 + fr * 4) = w; }
            }
        }
        __syncthreads();
    }
}

DI void rwkv_post_tile(int j, int item, LAS unsigned char* lds) {
    const int tile = item >> 2, ncq = item & 3;
    unsigned char* ws = WSP();
    const int tid = tid_opaque(), wave = __builtin_amdgcn_readfirstlane(tid >> 6), lane = tid & 63, fr = lane & 15, fq = lane >> 4;
    LAS bf16_t* As = (LAS bf16_t*)lds; LAS bf16_t* Bs = As + 128 * 200;
    const bf16_t* G1 = (const bf16_t*)(ws + OD_G1); const bf16_t* G2 = (const bf16_t*)(ws + W_G2_T) + (size_t)j * D * 192;
    const bf16_t* Y0 = (const bf16_t*)(ws + OD_Y); const bf16_t* Y1 = Y0 + (size_t)M * D;
    const bf16_t* Vb = (const bf16_t*)(ws + OD_RKV) + (size_t)2 * M * D; bf16_t* Yo = (bf16_t*)(ws + OD_RKV);
    const float* SB0 = (const float*)(ws + OD_SB); const float* SB1 = SB0 + (size_t)M * 16;
    const float* lng = IN(31) + j * D; const float* lnb = IN(32) + j * D;
    const int m0 = tile * 128;
    __syncthreads();
    for (int i = 0; i < 6; ++i) { const int idx = tid + 512 * i; const int row = idx / 24, ch = idx - row * 24;
        *(LAS u32x4*)(As + row * 200 + ch * 8) = *(const u32x4*)(G1 + (size_t)(m0 + row) * 256 + ch * 8); }
    const size_t m = (size_t)m0 + wave * 16 + fr;
    for (int nc = ncq * 2; nc < ncq * 2 + 2; ++nc) {
        __syncthreads();
        for (int i = 0; i < 6; ++i) { const int idx = tid + 512 * i; const int row = idx / 24, ch = idx - row * 24;
            *(LAS u32x4*)(Bs + row * 200 + ch * 8) = *(const u32x4*)(G2 + (size_t)(nc * 128 + row) * 192 + ch * 8); }
        __syncthreads();
        f32x4 acc[8];
#pragma unroll
        for (int i = 0; i < 8; ++i) acc[i] = (f32x4){0.f, 0.f, 0.f, 0.f};
        mm16<8, 6>(As + wave * 16 * 200, 200, Bs, 200, acc, fr, fq);
#pragma unroll
        for (int hh = 0; hh < 2; ++hh) {
            const int H = nc * 2 + hh; float y[4][4]; float sum = 0.f;
#pragma unroll
            for (int q = 0; q < 4; ++q) { const int c = nc * 128 + (hh * 4 + q) * 16 + fq * 4;
                const u32x2 a = *(const u32x2*)(Y0 + m * D + c), bq = *(const u32x2*)(Y1 + m * D + c);
                y[q][0] = bflo(a.x) + bflo(bq.x); y[q][1] = bfhi(a.x) + bfhi(bq.x); y[q][2] = bflo(a.y) + bflo(bq.y); y[q][3] = bfhi(a.y) + bfhi(bq.y);
                sum += y[q][0] + y[q][1] + y[q][2] + y[q][3]; }
            sum += __shfl_xor(sum, 16); sum += __shfl_xor(sum, 32);
            const float mean = sum * (1.f / 64.f); float vs = 0.f;
#pragma unroll
            for (int q = 0; q < 4; ++q)
#pragma unroll
                for (int e = 0; e < 4; ++e) { y[q][e] -= mean; vs += y[q][e] * y[q][e]; }
            vs += __shfl_xor(vs, 16); vs += __shfl_xor(vs, 32);
            const float rstd = rsqrtf(vs * (1.f / 64.f) + 64e-5f);
            const float sb = SB0[m * 16 + H] + SB1[m * 16 + H];
#pragma unroll
            for (int q = 0; q < 4; ++q) { const int c = nc * 128 + (hh * 4 + q) * 16 + fq * 4;
                const u32x2 vu = *(const u32x2*)(Vb + m * D + c); const float vf[4] = {bflo(vu.x), bfhi(vu.x), bflo(vu.y), bfhi(vu.y)};
                float o[4];
#pragma unroll
                for (int e = 0; e < 4; ++e) o[e] = (y[q][e] * rstd * lng[c + e] + lnb[c + e] + sb * vf[e]) * acc[hh * 4 + q][e];
                u32x2 w; w.x = pk2(o[0], o[1]); w.y = pk2(o[2], o[3]);
                *(u32x2*)(Yo + m * D + c) = w; }
        }
    }
    __syncthreads();
}


constexpr size_t WS_BAR = WS_TAB + 131072;
#define XB_TMO      128
#define XB_XCNT(j)  (256  + 64 * (j))
#define XB_XSUB(j)  (1280 + 64 * (j))
#define XB_XGEN(j)  (2304 + 64 * (j))
#define XB_TOP      3328
#define XB_TOPGEN   3392
#define XCD_BAR_WORDS 3456
#define XB_SPIN_CAP (1u << 20)
DI unsigned xb_ld(unsigned* p)              { return __hip_atomic_load(p, __ATOMIC_RELAXED, __HIP_MEMORY_SCOPE_AGENT); }
DI unsigned xb_add(unsigned* p, unsigned v) { return __hip_atomic_fetch_add(p, v, __ATOMIC_RELAXED, __HIP_MEMORY_SCOPE_AGENT); }
DI unsigned xb_xcc_id() { return (unsigned)__builtin_amdgcn_s_getreg((3 << 11) | 20) & 0xFu; }
#define XB_SPIN(cond, bar) do { unsigned _sp = 0; while (cond) { __builtin_amdgcn_s_sleep(1); \
    if ((++_sp & 255u) == 0u) { if (xb_ld(&(bar)[XB_TMO])) break; if (_sp > XB_SPIN_CAP) { atomicAdd(&(bar)[XB_TMO], 1u); break; } } } } while (0)
struct XcdBarrier { unsigned* bar; unsigned x; volatile LAS unsigned* st; };
DI XcdBarrier xcd_barrier_post(unsigned* bar, volatile LAS unsigned* st) {
    XcdBarrier b; b.bar = bar; b.x = xb_xcc_id(); b.st = st;
    if (threadIdx.x == 0) (void)xb_add(&bar[XB_XCNT(b.x)], 1u);
    return b;
}
DI void xcd_barrier_complete(unsigned* bar, unsigned x, unsigned& nloc, unsigned& nx) {
    const unsigned G = GDIM() * gridDim.y * gridDim.z;
    unsigned sum, cnt, mine, sp = 0u;
    for (;;) {
        sum = 0u; cnt = 0u; mine = 0u;
#pragma unroll
        for (unsigned j = 0; j < 16; ++j) { const unsigned c = xb_ld(&bar[XB_XCNT(j)]); sum += c; cnt += (c > 0u) ? 1u : 0u; mine = (j == x) ? c : mine; }
        if (sum == G) break;
        __builtin_amdgcn_s_sleep(1);
        if ((++sp & 255u) == 0u) { if (xb_ld(&bar[XB_TMO])) break; if (sp > XB_SPIN_CAP) { atomicAdd(&bar[XB_TMO], 1u); break; } }
    }
    nloc = mine > 0u ? mine : 1u; nx = cnt > 0u ? cnt : 1u;
}
DI void xcd_barrier(const XcdBarrier& b) {
    asm volatile("s_waitcnt vmcnt(0) lgkmcnt(0)" ::: "memory");
    __syncthreads();
    if (threadIdx.x == 0) {
        unsigned* bar = b.bar;
        __builtin_amdgcn_s_waitcnt(0);
        unsigned nloc = b.st[0], nx = b.st[1];
        if (nloc == 0u) { xcd_barrier_complete(bar, b.x, nloc, nx); b.st[0] = nloc; b.st[1] = nx; }
        const unsigned old = xb_add(&bar[XB_XSUB(b.x)], 1u);
        const unsigned gen = old / nloc;
        if (old + 1u == (gen + 1u) * nloc) {
            __builtin_amdgcn_fence(__ATOMIC_RELEASE, "agent");
            asm volatile("s_waitcnt vmcnt(0)" ::: "memory");
            const unsigned og = xb_add(&bar[XB_TOP], 1u);
            const unsigned tg = og / nx;
            if (og + 1u == (tg + 1u) * nx) xb_add(&bar[XB_TOPGEN], 1u);
            else XB_SPIN(xb_ld(&bar[XB_TOPGEN]) == tg, bar);
            __builtin_amdgcn_fence(__ATOMIC_ACQUIRE, "agent");
            xb_add(&bar[XB_XGEN(b.x)], 1u);
            asm volatile("s_waitcnt vmcnt(0)" ::: "memory");
        } else {
            XB_SPIN(xb_ld(&bar[XB_XGEN(b.x)]) == gen, bar);
            __builtin_amdgcn_fence(__ATOMIC_ACQUIRE, "agent");
            asm volatile("s_waitcnt vmcnt(0)" ::: "memory");
        }
    }
    __syncthreads();
}

DI void gsync(cg::grid_group& grid) {
    asm volatile("s_waitcnt vmcnt(0) lgkmcnt(0)" ::: "memory");
    grid.sync();
    asm volatile("" ::: "memory");
}
__global__ void __launch_bounds__(NTHREADS) fwd_megakernel(Params P) {
    extern __shared__ __attribute__((aligned(16))) unsigned char lds_raw[];
    LAS unsigned char* lds = (LAS unsigned char*)lds_raw;
    LAS unsigned char* ldsc = (LAS unsigned char*)16u;
    cg::grid_group grid = cg::this_grid();
    const int G = GDIM(), bid = BIDX();
    volatile LAS unsigned* xst = (volatile LAS unsigned*)(lds + 155136);
    if (threadIdx.x < 2) xst[threadIdx.x] = 0u;
    __syncthreads();
    const XcdBarrier xbar = xcd_barrier_post((unsigned*)(WSP() + WS_BAR), xst);

#pragma unroll 1
    for (int s = 0; s < 45; ++s) {
        int layer = 0, op = 0, q = 0;
        if (s > 0) { int r = s - 1;
            if (r < 8) layer = 0; else if (r < 22) { layer = 1; r -= 8; } else if (r < 30) { layer = 2; r -= 22; } else { layer = 3; r -= 30; }
            if ((layer & 1) == 0) op = r < 5 ? 1 + r : 11 + (r - 5);
            else { if (r < 8) { op = 6 + (r & 1); q = r >> 1; } else op = r < 11 ? 8 + (r - 8) : 11 + (r - 11); } }
        const int j = layer >> 1;
        const int bl = sgpr_opaque(bid), Gl = sgpr_opaque(G);
        LAS unsigned char* ldsl = lds; asm volatile("" : "+s"(ldsl));
        switch (op) {
        case 0: phase_setup(ldsl); break;
        case 1: phase_norm(layer, IN(6) + layer * D, 0, (bf16_t*)(WSP() + EV_H), layer == 0); break;
        case 2: { unsigned char* ws = WSP(); pg8::StaticOrder S; S.init(M / 256, 12, Gl, bl);
              ADense af{(const bf16_t*)(ws + EV_H), D};
              EpiEvenIn E{(bf16_t*)(ws + EV_P), (float*)(ws + EV_G), IN(11) + j * 2832};
              pg8::gemm_phase(ldsl, af, (const bf16_t*)(ws + W_IN_T) + (size_t)j * 3072 * D, D, D, S, E); } break;
        case 3: for (int it = bl; it < 256; it += Gl) mlstm_item(j, it, ldsc);
                for (int it = bl; it < 544; it += Gl) attn_tile(j, it, ldsc); break;
        case 4: phase_ml_combine(j); break;
        case 5: { unsigned char* ws = WSP(); pg8::StaticOrder S; S.init(M / 256, 4, Gl, bl);
              ADense af{(const bf16_t*)(ws + EV_P), PW};
              EpiResid E{ws, OUTP(), layer, 2, layer == 0 ? IN(2) : (const float*)(ws + WS_ZC), layer == 0 ? IN(0) : (const float*)OUTP()};
              pg8::gemm_phase(ldsl, af, (const bf16_t*)(ws + W_EVO_T) + (size_t)j * D * D, PW, D, S, E); } break;
        case 6: phase_rw_mix(layer, j, q, ldsc); break;
        case 7: { unsigned char* ws = WSP(); pg8::StaticOrder S; S.init(QROWS / 256, 15, Gl, bl);
              ARwkv af{(const bf16_t*)(ws + OD_XQ)};
              EpiRwkv E{(bf16_t*)(ws + OD_RKV), (bf16_t*)(ws + OD_L1), (bf16_t*)(ws + OD_G1), q * QROWS};
              pg8::gemm_phase(ldsl, af, (const bf16_t*)(ws + W_RKVL_T) + (size_t)j * 3840 * D, D, D, S, E); } break;
        case 8: for (int it = bl; it < 256; it += Gl) rwkv_scan_item(j, it, ldsc); break;
        case 9: for (int it = bl; it < (M / 128) * 4; it += Gl) { if (layer == 3 && ((it >> 2) % 34) < 2) continue; rwkv_post_tile(j, it, ldsc); } break;
        case 10: { unsigned char* ws = WSP(); pg8::StaticOrder S; S.init(M / 256, 4, Gl, bl, layer == 3);
              ADense af{(const bf16_t*)(ws + OD_RKV), D};
              EpiResid E{ws, OUTP(), layer, 2, (const float*)(ws + WS_ZC), (const float*)OUTP()};
              pg8::gemm_phase(ldsl, af, (const bf16_t*)(ws + W_RWO_T) + (size_t)j * D * D, D, D, S, E); } break;
        case 11: phase_norm(layer, IN(7) + layer * D, 3, (bf16_t*)(WSP() + ML_H), false); break;
        case 12: { unsigned char* ws = WSP(); pg8::StaticOrder S; S.init(M / 256, 16, Gl, bl, layer == 3);
              ADense af{(const bf16_t*)(ws + ML_H), D};
              EpiRelu2 E{(bf16_t*)(ws + ML_HID), FF};
              pg8::gemm_phase(ldsl, af, (const bf16_t*)(ws + W_M1_T) + (size_t)layer * FF * D, D, D, S, E); } break;
        default: { unsigned char* ws = WSP(); pg8::StaticOrder S; S.init(M / 256, 4, Gl, bl, layer == 3);
              ADense af{(const bf16_t*)(ws + ML_HID), FF};
              EpiResid E{ws, OUTP(), layer, 5, (const float*)(ws + WS_ZC), (const float*)OUTP()};
              pg8::gemm_phase(ldsl, af, (const bf16_t*)(ws + W_M2_T) + (size_t)layer * D * FF, FF, FF, S, E); } break;
        }
        if (s == 0) gsync(grid);
        else if (s < 44) xcd_barrier(xbar);
    }
}

extern "C" void kernel_launch(void* const* d_in, const int* in_sizes, int n_in, void* d_out, int out_size, void* d_ws, size_t ws_size, hipStream_t stream) {
    static int grid_blocks = 0;
    if (grid_blocks == 0) {
        if (n_in != 34 || ws_size < WS_NEED) { fprintf(stderr, "kernel_launch: unexpected n_in %d / ws_size %zu (need %zu)\n", n_in, ws_size, (size_t)WS_NEED); grid_blocks = -1; return; }
        int dev = 0, cus = 0, per_cu = 0;
        hipGetDevice(&dev);
        hipDeviceGetAttribute(&cus, hipDeviceAttributeMultiprocessorCount, dev);
        if (hipFuncSetAttribute((const void*)fwd_megakernel, hipFuncAttributeMaxDynamicSharedMemorySize, LDS_BYTES) != hipSuccess) fprintf(stderr, "kernel_launch: hipFuncSetAttribute failed\n");
        hipOccupancyMaxActiveBlocksPerMultiprocessor(&per_cu, (const void*)fwd_megakernel, NTHREADS, LDS_BYTES);
        (void)hipGetLastError();
        if (per_cu < 1) per_cu = 1;
        grid_blocks = cus * 1;
    }
    if (grid_blocks < 0) return;
    if (hipMemsetAsync((char*)d_ws + WS_BAR, 0, XCD_BAR_WORDS * 4, stream) != hipSuccess) { fprintf(stderr, "kernel_launch: hipMemsetAsync of the barrier words failed\n"); return; }
    Params p{};
    for (int i = 0; i < 34; ++i) p.in[i] = (const float*)d_in[i];
    p.out = (float*)d_out; p.ws = (unsigned char*)d_ws;
    void* args[] = {&p};
    hipError_t e = hipLaunchCooperativeKernel((const void*)fwd_megakernel, dim3(grid_blocks), dim3(NTHREADS), args, LDS_BYTES, stream);
    if (e != hipSuccess) fprintf(stderr, "cooperative launch failed: %s (grid %d)\n", hipGetErrorString(e), grid_blocks);
}
```

```cpp
#include <hip/hip_runtime.h>
#include <hip/hip_cooperative_groups.h>
#include <cstdint>
#include <cstdio>
namespace cg = cooperative_groups;

#define LAS __attribute__((address_space(3)))
#define DI __device__ __forceinline__
typedef unsigned short bf16_t;
typedef short bf16x8 __attribute__((ext_vector_type(8)));
typedef float f32x4 __attribute__((ext_vector_type(4)));
typedef unsigned u32x4 __attribute__((ext_vector_type(4)));
typedef unsigned u32x2 __attribute__((ext_vector_type(2)));
typedef float f32x2 __attribute__((ext_vector_type(2)));

constexpr int NB = 8, LC = 256, SL = 4096, T = LC + SL, D = 1024, M = NB * T, FF = 4096;
constexpr int PW = 2816;
constexpr int QROWS = 2 * T;
constexpr int NTHREADS = 512;
constexpr int LDS_BYTES = 155648;
#ifndef PH
#define PH 0x7fff
#endif

constexpr size_t MiB = 1u << 20;
constexpr size_t WS_ZC = 0;
constexpr size_t WS_MOD = 8 * MiB;
constexpr size_t WS_TAB = 9 * MiB;
constexpr size_t WS_W = 10 * MiB;
constexpr size_t W_IN_T = WS_W;
constexpr size_t W_EVO_T = W_IN_T + 12 * MiB;
constexpr size_t W_M1_T = W_EVO_T + 4 * MiB;
constexpr size_t W_M2_T = W_M1_T + 32 * MiB;
constexpr size_t W_RKVL_T = W_M2_T + 32 * MiB;
constexpr size_t W_RWO_T = W_RKVL_T + 15 * MiB;
constexpr size_t W_2W_T = W_RWO_T + 4 * MiB;
constexpr size_t W_2A_T = W_2W_T + MiB / 2;
constexpr size_t W_G2_T = W_2A_T + MiB / 2;
constexpr size_t RA = 112 * MiB;
constexpr size_t EV_H = RA;
constexpr size_t EV_P = RA + 68 * MiB;
constexpr size_t EV_G = RA + 255 * MiB;
constexpr size_t EV_HB = RA + 258 * MiB;
constexpr size_t ML_H = RA;
constexpr size_t ML_HID = RA + 68 * MiB;
constexpr size_t OD_XQ = RA;
constexpr size_t OD_Y = RA;
constexpr size_t OD_RKV = RA + 136 * MiB;
constexpr size_t OD_L1 = RA + 340 * MiB;
constexpr size_t OD_G1 = RA + 357 * MiB;
constexpr size_t OD_SB = RA + 374 * MiB;
constexpr size_t WS_NEED = RA + 380 * MiB;

struct Params { const float* in[34]; float* out; unsigned char* ws; };
#define CAS __attribute__((address_space(4)))
__device__ __forceinline__ const void* kload(int off) {
    const CAS char* base = (const CAS char*)__builtin_amdgcn_kernarg_segment_ptr();
    asm volatile("" : "+s"(base));
    return *(const void* const CAS*)(base + off);
}
#define IN(k) ((const float*)kload(8 * (k)))
#define OUTP() ((float*)kload(272))
#define WSP() ((unsigned char*)kload(280))

DI unsigned f2bf(float f) { unsigned u = __builtin_bit_cast(unsigned, f); return (u + 0x7fffu + ((u >> 16) & 1u)) >> 16; }
DI unsigned pk2(float lo, float hi) { return f2bf(lo) | (f2bf(hi) << 16); }
DI float bflo(unsigned u) { return __builtin_bit_cast(float, u << 16); }
DI float bfhi(unsigned u) { return __builtin_bit_cast(float, u & 0xffff0000u); }
DI float bf1(bf16_t h) { return __builtin_bit_cast(float, ((unsigned)h) << 16); }
DI float sigmoidf_(float x) { return 1.f / (1.f + __expf(-x)); }
DI float tanhf_(float x) { float e = __expf(2.f * x); return 1.f - 2.f / (e + 1.f); }
DI float softcap_(float u) { return 15.f * tanhf_(u * (1.f / 15.f)); }
template <int CTRL> DI float dppmov(float x) { return __builtin_bit_cast(float, __builtin_amdgcn_update_dpp(0, __builtin_bit_cast(int, x), CTRL, 0xf, 0xf, true)); }
DI float red16(float x) { x += dppmov<0xB1>(x); x += dppmov<0x4E>(x); x += dppmov<0x141>(x); x += dppmov<0x140>(x); return x; }
DI float red8(float x) { x += dppmov<0xB1>(x); x += dppmov<0x4E>(x); x += dppmov<0x141>(x); return x; }
DI float red4(float x) { x += dppmov<0xB1>(x); x += dppmov<0x4E>(x); return x; }
DI int sgpr_opaque(int v) { asm volatile("" : "+s"(v)); return v; }
#define BIDX() sgpr_opaque((int)__builtin_amdgcn_workgroup_id_x())
#define GDIM() sgpr_opaque((int)__ockl_get_num_groups(0))
DI int tid_opaque() { int t = threadIdx.x; asm volatile("" : "+v"(t)); return t; }
DI float wave_sum(float v) {
#pragma unroll
    for (int o = 1; o < 64; o <<= 1) v += __shfl_xor(v, o);
    return v;
}
DI int tok_of(int d, int i) { if (i < LC) return d ? (LC - 1 - i) : i; return d ? (LC + SL - 1 - (i - LC)) : i; }
DI float* zrow(unsigned char* ws, float* out, int m) {
    const int b = m / T, t = m - b * T;
    return t < LC ? (float*)(ws + WS_ZC) + (size_t)(b * LC + t) * D : out + (size_t)(b * SL + t - LC) * D;
}
DI const float* zrow_src(const float* zc, const float* zl, int m) {
    const int b = m / T, t = m - b * T;
    return t < LC ? zc + (size_t)(b * LC + t) * D : zl + (size_t)(b * SL + t - LC) * D;
}
DI const float* modp(const unsigned char* ws, int layer, int who, int idx) { return (const float*)(ws + WS_MOD) + ((size_t)(layer * 9 + who) * 6 + idx) * D; }

template <int NT, int KS>
DI void mm16(const LAS bf16_t* A, int lda, const LAS bf16_t* B, int ldb, f32x4 (&acc)[NT], int fr, int fq) {
#pragma unroll
    for (int ks = 0; ks < KS; ++ks) {
        const bf16x8 a = *(const LAS bf16x8*)(A + fr * lda + ks * 32 + fq * 8);
#pragma unroll
        for (int nt = 0; nt < NT; ++nt) {
            const bf16x8 b = *(const LAS bf16x8*)(B + (nt * 16 + fr) * ldb + ks * 32 + fq * 8);
            acc[nt] = __builtin_amdgcn_mfma_f32_16x16x32_bf16(b, a, acc[nt], 0, 0, 0);
        }
    }
}

namespace pg8 {
constexpr int BM = 256, BK = 64, HALF = 128, HTB = HALF * BK * 2, NXCD = 8, WGM = 8;
__host__ __device__ __forceinline__ int lds_byte(int r, int c) { const int st = (r >> 4) * 2 + (c >> 5), rr = r & 15, cc = c & 31, ob = rr * 64 + cc * 2; return st * 1024 + (ob ^ (((ob >> 9) & 1) << 5)); }
__host__ __device__ __forceinline__ void stage_rc(int b, int& R, int& C) { const int st = b / 1024, sb = b % 1024, swz = sb ^ (((sb >> 9) & 1) << 5); R = (st >> 1) * 16 + swz / 64; C = (st & 1) * 32 + (swz % 64) / 2; }
__host__ __device__ __forceinline__ int perm32(int rho) { const int n = rho >> 4, i = rho & 15; return 8 * (i >> 2) + 4 * n + (i & 3); }
struct Unit { int pm, pn; };
struct StaticOrder {
    int nM, nN, nwg, G, c, skipctx;
    __device__ void init(int nM_, int nN_, int G_, int c_, int skipctx_ = 0) { skipctx = skipctx_; nM = skipctx_ ? nM_ / 17 * 16 : nM_; nN = nN_; nwg = nM * nN; G = G_; c = c_; }
    __device__ bool next(int i, Unit& u) const {
        const long L = (long)i * G + c; if (L >= nwg) return false;
        int wgid = (int)L; { const int q = nwg / NXCD, r = nwg % NXCD, xcd = wgid % NXCD, off = wgid / NXCD; wgid = (xcd < r ? xcd * (q + 1) : r * (q + 1) + (xcd - r) * q) + off; }
        const int nig = WGM * nN, gid = wgid / nig, fm = gid * WGM, gsz = (nM - fm) < WGM ? (nM - fm) : WGM;
        u.pm = fm + ((wgid % nig) % gsz); u.pn = (wgid % nig) / gsz; if (skipctx) u.pm = (u.pm >> 4) * 17 + 1 + (u.pm & 15); return true;
    }
};
DI unsigned cvt_pk_bf16(float lo, float hi) { unsigned r; asm volatile("v_cvt_pk_bf16_f32 %0, %1, %2" : "=v"(r) : "v"(lo), "v"(hi)); return r; }

template <class AF, class Epi>
DI void gemm_phase(LAS unsigned char* lds, const AF& af, const bf16_t* Bt, int lda, int K, const StaticOrder& S, const Epi& E) {
    const int tid = tid_opaque(), wid = __builtin_amdgcn_readfirstlane(tid >> 6), lane = tid & 63, wr = wid >> 2, wc = wid & 3, fr = lane & 15, fq = lane >> 4;
    const int nt = K / BK;
    unsigned voffA[2], voffB[2];
#pragma unroll
    for (int i = 0; i < 2; ++i) { int R, C; stage_rc(tid * 16 + i * 8192, R, C); const int Rb = (R & ~31) + perm32(R & 31);
        voffA[i] = (unsigned)(R * lda + C) * 2u; voffB[i] = (unsigned)(Rb * K + C) * 2u; }
    const size_t kstep = (size_t)(BK * 2);
    const size_t hstepA = (size_t)HALF * lda * 2, hstepB = (size_t)HALF * K * 2;
    const unsigned ldsw = (unsigned)wid * 1024u;
    const int aoff = lds_byte(wr * 64 + fr, fq * 8), boff = lds_byte(wc * 32 + fr, fq * 8);
#define PG8_SA(b, h) (((b) * 2 + (h)) * HTB)
#define PG8_SB(b, h) ((4 + (b) * 2 + (h)) * HTB)
#define PG8_STAGE(bufoff, gbase, voff) do { _Pragma("unroll") for (int _i = 0; _i < 2; ++_i) \
        __builtin_amdgcn_global_load_lds((const unsigned*)((const char*)(gbase) + (voff)[_i]), (LAS unsigned*)(lds + (bufoff) + ldsw + _i * 8192), 16, 0, 0); } while (0)
#define PG8_LDA(dst, b, h) do { _Pragma("unroll") for (int m = 0; m < 4; ++m) _Pragma("unroll") for (int k = 0; k < 2; ++k) dst[m][k] = *(const LAS bf16x8*)(lds + PG8_SA(b, h) + aoff + m * 2048 + k * 1024); } while (0)
#define PG8_LDB(dst, b, h) do { _Pragma("unroll") for (int n = 0; n < 2; ++n) _Pragma("unroll") for (int k = 0; k < 2; ++k) dst[n][k] = *(const LAS bf16x8*)(lds + PG8_SB(b, h) + boff + n * 2048 + k * 1024); } while (0)
#define PG8_MMA(ai, bj, At, Bt_) do { __builtin_amdgcn_s_setprio(1); _Pragma("unroll") for (int m = 0; m < 4; ++m) _Pragma("unroll") for (int n = 0; n < 2; ++n) _Pragma("unroll") for (int k = 0; k < 2; ++k) \
        acc[ai][bj][m][n] = __builtin_amdgcn_mfma_f32_16x16x32_bf16(Bt_[n][k], At[m][k], acc[ai][bj][m][n], 0, 0, 0); __builtin_amdgcn_s_setprio(0); } while (0)
#define PG8_WAIT_V(n) asm volatile("s_waitcnt vmcnt(" #n ")" ::: "memory")
#define PG8_WAIT_L(n) asm volatile("s_waitcnt lgkmcnt(" #n ")" ::: "memory")
#define PG8_BAR __builtin_amdgcn_s_barrier()
#define PG8_SCHED __builtin_amdgcn_sched_barrier(0)
    Unit cur, nxt; int ui = 0;
    if (!S.next(0, cur)) return;
    f32x4 acc[2][2][4][2];
#pragma unroll
    for (int a = 0; a < 2; ++a)
#pragma unroll
        for (int b = 0; b < 2; ++b)
#pragma unroll
            for (int m = 0; m < 4; ++m)
#pragma unroll
                for (int n = 0; n < 2; ++n) acc[a][b][m][n] = (f32x4){0.f, 0.f, 0.f, 0.f};
    bf16x8 At[4][2], B0[2][2], B1[2][2];
    const char* cA = af.a(cur.pm, cur.pn); const char* cB = (const char*)Bt + (size_t)cur.pn * 2 * hstepB;
    PG8_STAGE(PG8_SB(0, 0), cB, voffB); PG8_STAGE(PG8_SB(0, 1), cB + hstepB, voffB); PG8_STAGE(PG8_SA(0, 0), cA, voffA); PG8_STAGE(PG8_SA(0, 1), cA + hstepA, voffA);
    if (wr == 1) PG8_BAR;
    PG8_WAIT_V(2); PG8_BAR;
    PG8_STAGE(PG8_SB(1, 0), cB + kstep, voffB); PG8_STAGE(PG8_SA(1, 0), cA + kstep, voffA); PG8_STAGE(PG8_SB(1, 1), cB + hstepB + kstep, voffB);
    PG8_WAIT_V(6); PG8_BAR;
    for (;;) {
        const bool has_next = S.next(ui + 1, nxt);
        const char* nA = has_next ? af.a(nxt.pm, nxt.pn) : cA; const char* nB = has_next ? (const char*)Bt + (size_t)nxt.pn * 2 * hstepB : cB;
        for (int t = 0; t < nt; t += 2) {
            const bool last = (t == nt - 2);
            const char* a1 = cA + (size_t)(t + 1) * kstep;
            const char* a2 = last ? nA : cA + (size_t)(t + 2) * kstep; const char* b2 = last ? nB : cB + (size_t)(t + 2) * kstep;
            const char* a3 = a2 + kstep; const char* b3 = b2 + kstep;
            PG8_LDB(B0, 0, 0); PG8_LDB(B1, 0, 1); PG8_SCHED; PG8_LDA(At, 0, 0); PG8_STAGE(PG8_SA(1, 1), a1 + hstepA, voffA);
            PG8_WAIT_V(8); PG8_WAIT_L(0); PG8_BAR; PG8_MMA(0, 0, At, B0); PG8_MMA(0, 1, At, B1); PG8_BAR; PG8_SCHED;
            PG8_LDA(At, 0, 1); PG8_STAGE(PG8_SB(0, 0), b2, voffB); PG8_STAGE(PG8_SB(0, 1), b2 + hstepB, voffB); PG8_STAGE(PG8_SA(0, 0), a2, voffA);
            PG8_WAIT_V(8); PG8_WAIT_L(0); PG8_BAR; PG8_MMA(1, 0, At, B0); PG8_MMA(1, 1, At, B1); PG8_BAR; PG8_SCHED;
            PG8_LDB(B0, 1, 0); PG8_LDB(B1, 1, 1); PG8_SCHED; PG8_LDA(At, 1, 0); PG8_STAGE(PG8_SA(0, 1), a2 + hstepA, voffA);
            PG8_WAIT_V(8); PG8_WAIT_L(0); PG8_BAR; PG8_MMA(0, 0, At, B0); PG8_MMA(0, 1, At, B1); PG8_BAR; PG8_SCHED;
            PG8_LDA(At, 1, 1); PG8_STAGE(PG8_SB(1, 0), b3, voffB); PG8_STAGE(PG8_SB(1, 1), b3 + hstepB, voffB); PG8_STAGE(PG8_SA(1, 0), a3, voffA);
            PG8_WAIT_V(8); PG8_WAIT_L(0); PG8_BAR; PG8_MMA(1, 0, At, B0); PG8_MMA(1, 1, At, B1); PG8_BAR; PG8_SCHED;
        }
        if (wr == 0) PG8_BAR;
        E(acc, cur, wr, wc, fr, fq);
        if (!has_next) break;
#pragma unroll
        for (int a = 0; a < 2; ++a)
#pragma unroll
            for (int b = 0; b < 2; ++b)
#pragma unroll
                for (int m = 0; m < 4; ++m)
#pragma unroll
                    for (int n = 0; n < 2; ++n) acc[a][b][m][n] = (f32x4){0.f, 0.f, 0.f, 0.f};
        cur = nxt; cA = nA; cB = nB; ++ui;
        if (wr == 1) PG8_BAR;
    }
    PG8_WAIT_V(0);
    PG8_BAR;
#undef PG8_SA
#undef PG8_SB
#undef PG8_STAGE
#undef PG8_LDA
#undef PG8_LDB
#undef PG8_MMA
#undef PG8_WAIT_V
#undef PG8_WAIT_L
#undef PG8_BAR
#undef PG8_SCHED
}
}
using pg8::Unit;

struct ADense { const bf16_t* A; int lda; DI const char* a(int pm, int) const { return (const char*)(A + (size_t)pm * 256 * lda); } };
struct ARwkv { const bf16_t* X; DI const char* a(int pm, int pn) const {
        const int sel = pn < 4 ? 0 : pn < 8 ? 2 : pn < 12 ? 3 : pn == 12 ? 1 : pn == 13 ? 4 : 5;
        return (const char*)(X + (size_t)sel * QROWS * D + (size_t)pm * 256 * D); } };

DI int evmap(int n) {
    if (n < 512) return n; if (n < 1024) return 2064 + (n - 512); if (n < 1536) return 512 + (n - 1024); if (n < 2048) return 1024 + (n - 1536);
    if (n < 2560) return 1536 + (n - 2048); if (n < 2688) return 2576 + (n - 2560); if (n < 2816) return 2704 + (n - 2688); if (n < 2832) return 2048 + (n - 2816); return -1;
}
struct EpiEvenIn {
    bf16_t* Pb; float* G; const float* bias;
    DI void operator()(const f32x4 (&acc)[2][2][4][2], const Unit& u, int wr, int wc, int fr, int fq) const {
        const int row0 = u.pm * 256 + wr * 64 + fr;
#pragma unroll
        for (int bj = 0; bj < 2; ++bj) {
            const int col = u.pn * 256 + bj * 128 + wc * 32 + 8 * fq;
            const int oc = evmap(col);
            if (oc < 0) continue;
            const f32x4 b0 = *(const f32x4*)(bias + oc), b1 = *(const f32x4*)(bias + oc + 4);
#pragma unroll
            for (int ai = 0; ai < 2; ++ai)
#pragma unroll
                for (int m = 0; m < 4; ++m) {
                    const int row = row0 + ai * 128 + m * 16;
                    const f32x4 v0 = acc[ai][bj][m][0] + b0, v1 = acc[ai][bj][m][1] + b1;
                    if (col < 2816) { u32x4 w; w.x = pg8::cvt_pk_bf16(v0[0], v0[1]); w.y = pg8::cvt_pk_bf16(v0[2], v0[3]); w.z = pg8::cvt_pk_bf16(v1[0], v1[1]); w.w = pg8::cvt_pk_bf16(v1[2], v1[3]);
                        *(u32x4*)(Pb + (size_t)row * PW + col) = w; }
                    else { float* g = G + (size_t)row * 16 + (col - 2816); *(f32x4*)g = v0; *(f32x4*)(g + 4) = v1; }
                }
        }
    }
};
struct EpiRelu2 {
    bf16_t* O; int ldc;
    DI void operator()(const f32x4 (&acc)[2][2][4][2], const Unit& u, int wr, int wc, int fr, int fq) const {
        const int row0 = u.pm * 256 + wr * 64 + fr, col0 = u.pn * 256 + wc * 32 + 8 * fq;
#pragma unroll
        for (int ai = 0; ai < 2; ++ai)
#pragma unroll
            for (int m = 0; m < 4; ++m)
#pragma unroll
                for (int bj = 0; bj < 2; ++bj) {
                    f32x4 v0 = acc[ai][bj][m][0], v1 = acc[ai][bj][m][1];
#pragma unroll
                    for (int e = 0; e < 4; ++e) { float a = fmaxf(v0[e], 0.f); v0[e] = a * a; float b = fmaxf(v1[e], 0.f); v1[e] = b * b; }
                    u32x4 w; w.x = pg8::cvt_pk_bf16(v0[0], v0[1]); w.y = pg8::cvt_pk_bf16(v0[2], v0[3]); w.z = pg8::cvt_pk_bf16(v1[0], v1[1]); w.w = pg8::cvt_pk_bf16(v1[2], v1[3]);
                    *(u32x4*)(O + (size_t)(row0 + ai * 128 + m * 16) * ldc + col0 + bj * 128) = w;
                }
    }
};
struct EpiResid {
    unsigned char* ws; float* out; int layer, gidx; const float* zcs; const float* zls;
    DI void operator()(const f32x4 (&acc)[2][2][4][2], const Unit& u, int wr, int wc, int fr, int fq) const {
        const int b = u.pm / 17, jt = u.pm - b * 17;
        const int who = jt == 0 ? 8 : b;
        const float* gate = modp(ws, layer, who, gidx);
        float* zb = jt == 0 ? (float*)(ws + WS_ZC) + (size_t)(b * LC) * D : out + (size_t)(b * SL + (jt - 1) * 256) * D;
        const float* zs = jt == 0 ? zcs + (size_t)(b * LC) * D : zls + (size_t)(b * SL + (jt - 1) * 256) * D;
        const int r0 = wr * 64 + fr, col0 = u.pn * 256 + wc * 32 + 8 * fq;
#pragma unroll
        for (int ai = 0; ai < 2; ++ai)
#pragma unroll
            for (int m = 0; m < 4; ++m)
#pragma unroll
                for (int bj = 0; bj < 2; ++bj) {
                    const int col = col0 + bj * 128;
                    const f32x4 g0 = *(const f32x4*)(gate + col), g1 = *(const f32x4*)(gate + col + 4);
                    const size_t zo = (size_t)(r0 + ai * 128 + m * 16) * D + col; float* zp = zb + zo; const float* zq = zs + zo;
                    f32x4 z0 = *(const f32x4*)zq, z1 = *(const f32x4*)(zq + 4);
                    z0 += g0 * acc[ai][bj][m][0]; z1 += g1 * acc[ai][bj][m][1];
                    *(f32x4*)zp = z0; *(f32x4*)(zp + 4) = z1;
                    __builtin_amdgcn_sched_barrier(0);
                }
    }
};
struct EpiRwkv {
    bf16_t* RKV; bf16_t* L1; bf16_t* G1; int rowbase;
    DI void operator()(const f32x4 (&acc)[2][2][4][2], const Unit& u, int wr, int wc, int fr, int fq) const {
        const int row0 = rowbase + u.pm * 256 + wr * 64 + fr;
#pragma unroll
        for (int bj = 0; bj < 2; ++bj) {
            const int c = bj * 128 + wc * 32 + 8 * fq;
            if (u.pn >= 12 && u.pn < 14 && bj == 1) continue;
#pragma unroll
            for (int ai = 0; ai < 2; ++ai)
#pragma unroll
                for (int m = 0; m < 4; ++m) {
                    const int row = row0 + ai * 128 + m * 16;
                    f32x4 v0 = acc[ai][bj][m][0], v1 = acc[ai][bj][m][1];
                    bf16_t* dst;
                    if (u.pn < 12) dst = RKV + (size_t)(u.pn >> 2) * M * D + (size_t)row * D + (u.pn & 3) * 256 + c;
                    else if (u.pn == 12) {
#pragma unroll
                        for (int e = 0; e < 4; ++e) { v0[e] = tanhf_(v0[e]); v1[e] = tanhf_(v1[e]); }
                        dst = L1 + (size_t)row * 256 + c;
                    } else if (u.pn == 13) dst = L1 + (size_t)row * 256 + 128 + c;
                    else {
#pragma unroll
                        for (int e = 0; e < 4; ++e) { v0[e] = c < 160 ? sigmoidf_(v0[e]) : 0.f; v1[e] = c < 160 ? sigmoidf_(v1[e]) : 0.f; }
                        dst = G1 + (size_t)row * 256 + c;
                    }
                    u32x4 w; w.x = pg8::cvt_pk_bf16(v0[0], v0[1]); w.y = pg8::cvt_pk_bf16(v0[2], v0[3]); w.z = pg8::cvt_pk_bf16(v1[0], v1[1]); w.w = pg8::cvt_pk_bf16(v1[2], v1[3]);
                    *(u32x4*)dst = w;
                }
        }
    }
};

DI int colmap(int kind, int n) {
    if (kind == 0) return n;
    if (kind == 1) return evmap(n);
    if (kind == 2) return n < 128 ? (n >> 6) * 65536 + (n & 63) : -1;
    return n < 160 ? n : -1;
}
DI void transpose_tiles(const float* src, int ldw, int Ks, bf16_t* dst, int Nn, int Kd, int kind, LAS float* tile) {
    const int tid = tid_opaque(), ntn = Nn / 64, ntk = Kd / 64;
    for (int it = BIDX(); it < ntn * ntk; it += GDIM()) {
        const int n0 = (it % ntn) * 64, k0 = (it / ntn) * 64;
        { const int nn = tid & 63, kk = tid >> 6; const int off = colmap(kind, n0 + nn);
#pragma unroll
          for (int i = 0; i < 8; ++i) { const int k = k0 + kk + 8 * i; float v = 0.f; if (off >= 0 && k < Ks) v = src[(size_t)k * ldw + off]; tile[(kk + 8 * i) * 65 + nn] = v; } }
        __syncthreads();
        { const int nn = tid >> 3, kc = tid & 7; const LAS float* s = tile + (kc * 8) * 65 + nn;
          u32x4 o; o.x = pk2(s[0], s[65]); o.y = pk2(s[2 * 65], s[3 * 65]); o.z = pk2(s[4 * 65], s[5 * 65]); o.w = pk2(s[6 * 65], s[7 * 65]);
          *(u32x4*)(dst + (size_t)(n0 + nn) * Kd + k0 + kc * 8) = o; }
        __syncthreads();
    }
}
DI void phase_setup(LAS unsigned char* lds) {
    const int tid = tid_opaque(), G = GDIM(); unsigned char* ws = WSP();
    if (BIDX() == 0) { float* tab = (float*)(ws + WS_TAB);
        for (int e = tid; e < 1024; e += NTHREADS) { const int pos = e >> 4, i = e & 15;
            const float inv = exp2f(-(float)i * 0.83048202372184058696f);
            const float ang = (float)pos * inv; const float k = rintf(ang * 0.15915494309189533577f);
            float r = fmaf(-k, 6.28125f, ang); r = fmaf(-k, 1.9353071795864769e-3f, r);
            tab[e] = __cosf(r); tab[1024 + e] = __sinf(r); } }
    { LAS float* sv = (LAS float*)lds;
      LAS float* red = sv + 9 * 1024;
      { const float* cin = IN(1); const float* cctx = IN(3);
      for (int e = tid; e < 9 * 1024; e += NTHREADS) { const int who = e >> 10, k = e & 1023; const float c = who < 8 ? cin[who * D + k] : cctx[k]; sv[e] = c * sigmoidf_(c); } }
      const float* adaw = IN(4); const float* adab = IN(5);
      __syncthreads();
      for (int it = BIDX(); it < 4 * 48; it += G) {
          const int l = it / 48, n0 = (it % 48) * 128; const int kp = tid >> 7, nn = tid & 127;
          const float* w = adaw + (size_t)l * D * 6144 + n0 + nn;
          float a[9];
#pragma unroll
          for (int i = 0; i < 9; ++i) a[i] = 0.f;
          for (int k = kp * 256; k < kp * 256 + 256; ++k) { const float wv = w[(size_t)k * 6144];
#pragma unroll
              for (int i = 0; i < 9; ++i) a[i] = fmaf(sv[i * 1024 + k], wv, a[i]); }
#pragma unroll
          for (int i = 0; i < 9; ++i) red[(kp * 9 + i) * 128 + nn] = a[i];
          __syncthreads();
          if (kp == 0) { const float bias = adab[l * 6144 + n0 + nn];
#pragma unroll
              for (int i = 0; i < 9; ++i) { const float s = red[i * 128 + nn] + red[(9 + i) * 128 + nn] + red[(18 + i) * 128 + nn] + red[(27 + i) * 128 + nn];
                  ((float*)(ws + WS_MOD))[((size_t)(l * 9 + i)) * 6144 + n0 + nn] = s + bias; } }
          __syncthreads();
      } }
    LAS float* tile = (LAS float*)lds;
    for (int j = 0; j < 2; ++j) {
        transpose_tiles(IN(10) + (size_t)j * D * 2832, 2832, D, (bf16_t*)(ws + W_IN_T) + (size_t)j * 3072 * D, 3072, D, 1, tile);
        transpose_tiles(IN(12) + (size_t)j * D * D, D, D, (bf16_t*)(ws + W_EVO_T) + (size_t)j * D * D, D, D, 0, tile);
        for (int i = 0; i < 3; ++i) transpose_tiles(IN(19) + (size_t)(j * 3 + i) * D * D, D, D, (bf16_t*)(ws + W_RKVL_T) + (size_t)j * 3840 * D + (size_t)i * D * D, D, D, 0, tile);
        transpose_tiles(IN(21) + (size_t)j * 2 * D * 64, 64, D, (bf16_t*)(ws + W_RKVL_T) + (size_t)j * 3840 * D + (size_t)3072 * D, 256, D, 2, tile);
        transpose_tiles(IN(24) + (size_t)j * 2 * D * 64, 64, D, (bf16_t*)(ws + W_RKVL_T) + (size_t)j * 3840 * D + (size_t)3328 * D, 256, D, 2, tile);
        transpose_tiles(IN(26) + (size_t)j * D * 160, 160, D, (bf16_t*)(ws + W_RKVL_T) + (size_t)j * 3840 * D + (size_t)3584 * D, 256, D, 3, tile);
        for (int d = 0; d < 2; ++d) {
            transpose_tiles(IN(22) + (size_t)(j * 2 + d) * 64 * D, D, 64, (bf16_t*)(ws + W_2W_T) + (size_t)(j * 2 + d) * D * 64, D, 64, 0, tile);
            transpose_tiles(IN(25) + (size_t)(j * 2 + d) * 64 * D, D, 64, (bf16_t*)(ws + W_2A_T) + (size_t)(j * 2 + d) * D * 64, D, 64, 0, tile);
        }
        transpose_tiles(IN(27) + (size_t)j * 160 * D, D, 160, (bf16_t*)(ws + W_G2_T) + (size_t)j * D * 192, D, 192, 0, tile);
        transpose_tiles(IN(33) + (size_t)j * D * D, D, D, (bf16_t*)(ws + W_RWO_T) + (size_t)j * D * D, D, D, 0, tile);
    }
    for (int l = 0; l < 4; ++l) {
        transpose_tiles(IN(8) + (size_t)l * D * FF, FF, D, (bf16_t*)(ws + W_M1_T) + (size_t)l * FF * D, FF, D, 0, tile);
        transpose_tiles(IN(9) + (size_t)l * FF * D, D, FF, (bf16_t*)(ws + W_M2_T) + (size_t)l * D * FF, D, FF, 0, tile);
    }
}

DI void phase_norm(int layer, const float* g, int sidx, bf16_t* dst, bool first) {
    const int tid0 = tid_opaque(); const int lane = tid0 & 63, wave = tid0 >> 6; unsigned char* ws = WSP();
    const float* zcs = first ? IN(2) : (const float*)(ws + WS_ZC); const float* zls = first ? IN(0) : (const float*)OUTP();
    const int nw = GDIM() * 8;
    for (int m0 = BIDX() * 8 + wave; m0 < M; m0 += 2 * nw) {
        const int m1 = m0 + nw; const bool has1 = m1 < M; const int m1c = has1 ? m1 : m0;
        const float* z0 = zrow_src(zcs, zls, m0); const float* z1 = zrow_src(zcs, zls, m1c);
        f32x4 v0[4], v1[4]; float ss0 = 0.f, ss1 = 0.f;
#pragma unroll
        for (int j = 0; j < 4; ++j) { v0[j] = *(const f32x4*)(z0 + 4 * lane + 256 * j); v1[j] = *(const f32x4*)(z1 + 4 * lane + 256 * j); }
#pragma unroll
        for (int j = 0; j < 4; ++j) { ss0 += v0[j][0] * v0[j][0] + v0[j][1] * v0[j][1] + v0[j][2] * v0[j][2] + v0[j][3] * v0[j][3]; ss1 += v1[j][0] * v1[j][0] + v1[j][1] * v1[j][1] + v1[j][2] * v1[j][2] + v1[j][3] * v1[j][3]; }
#pragma unroll
        for (int o = 1; o < 64; o <<= 1) { ss0 += __shfl_xor(ss0, o); ss1 += __shfl_xor(ss1, o); }
#pragma unroll
        for (int r = 0; r < 2; ++r) {
            if (r == 1 && !has1) break;
            const int m = r ? m1 : m0; const int b = m / T, t = m - b * T; const int who = t < LC ? 8 : b;
            const float* sh = modp(ws, layer, who, sidx); const float* sc = modp(ws, layer, who, sidx + 1);
            const float rstd = rsqrtf((r ? ss1 : ss0) * (1.f / D) + 1e-6f);
#pragma unroll
            for (int j = 0; j < 4; ++j) { const int c = 4 * lane + 256 * j;
                const f32x4 gg = *(const f32x4*)(g + c), s1 = *(const f32x4*)(sc + c), s0 = *(const f32x4*)(sh + c);
                f32x4 y = (r ? v1[j] : v0[j]) * rstd * gg; y = y * (s1 + 1.f) + s0;
                u32x2 w; w.x = pk2(y[0], y[1]); w.y = pk2(y[2], y[3]);
                *(u32x2*)(dst + (size_t)m * D + c) = w; }
        }
    }
}

DI void mlstm_item(int j, int item, LAS unsigned char* lds) {
    unsigned char* ws = WSP();
    const int tid = tid_opaque(), wave = __builtin_amdgcn_readfirstlane(tid >> 6), lane = tid & 63, fr = lane & 15, fq = lane >> 4;
    const int b = item >> 5, head = (item >> 3) & 3, d = (item >> 2) & 1, vq = item & 3;
    LAS bf16_t* Qs = (LAS bf16_t*)lds; LAS bf16_t* KPs = Qs + 128 * 136; LAS bf16_t* KTs = KPs + 128 * 136;
    LAS bf16_t* VTs = KTs + 128 * 136; LAS bf16_t* VWs = VTs + 48 * 136; LAS bf16_t* Cs = VWs + 48 * 136;
    LAS float* lfs = (LAS float*)(Cs + 48 * 136); LAS float* ics = lfs + 128; LAS float* gs = ics + 128; LAS float* bcs = gs + 128;
    LAS float* wss = bcs + 128; LAS float* ats = wss + 128; LAS float* scal = ats + 128;
    const bf16_t* Pb = (const bf16_t*)(ws + EV_P); const float* Gt = (const float*)(ws + EV_G);
    bf16_t* HB = (bf16_t*)(ws + EV_HB) + (size_t)d * M * 512;
    const float fb = IN(13)[(j * 2 + d) * 4 + head];
    const float scale = 0.08838834764831845f;
    __syncthreads();
    for (int e = tid; e < 48 * 136; e += NTHREADS) { const int r = e / 136; Cs[e] = 0; VWs[e] = 0; VTs[e] = (r == 32) ? (bf16_t)0x3F80 : (bf16_t)0; }
    f32x4 Ct[3];
#pragma unroll
    for (int i = 0; i < 3; ++i) Ct[i] = (f32x4){0.f, 0.f, 0.f, 0.f};
    float mst = 0.f;
    const int prow_ = tid >> 2, pcs_ = tid & 3;
    float pgi = 0.f, pgf = 0.f; u32x4 pq[4], pk[4], pv;
    { if (tid < 128) { const int mr = b * T + tok_of(d, tid); pgi = Gt[(size_t)mr * 16 + d * 8 + head]; pgf = Gt[(size_t)mr * 16 + d * 8 + 4 + head]; }
      const bf16_t* s0_ = Pb + (size_t)(b * T + tok_of(d, prow_)) * PW + head * 128;
#pragma unroll
      for (int i = 0; i < 4; ++i) { pq[i] = *(const u32x4*)(s0_ + pcs_ * 32 + i * 8); pk[i] = *(const u32x4*)(s0_ + 1024 + pcs_ * 32 + i * 8); }
      pv = *(const u32x4*)(s0_ + 1536 + vq * 32 + pcs_ * 8); }
    for (int p = 0; p < 34; ++p) {
        const int i0 = p * 128;
        if (tid < 128) { ics[tid] = softcap_(pgi); const float x = softcap_(pgf + fb); lfs[tid] = -__logf(1.f + __expf(-x)); }
        __syncthreads();
        if (wave == 0) {
            const float a0 = lfs[2 * lane], a1 = lfs[2 * lane + 1]; const float c1 = a0 + a1;
            float x = c1;
#pragma unroll
            for (int o = 1; o < 64; o <<= 1) { const float y = __shfl_up(x, o); if (lane >= o) x += y; }
            const float ex = x - c1; const float bc0 = ex + a0, bc1 = ex + c1;
            const float g0 = ics[2 * lane] - bc0, g1 = ics[2 * lane + 1] - bc1;
            float pm = fmaxf(g0, g1);
#pragma unroll
            for (int o = 1; o < 64; o <<= 1) { const float y = __shfl_up(pm, o); if (lane >= o) pm = fmaxf(pm, y); }
            float pe = __shfl_up(pm, 1); if (lane == 0) pe = -3.0e38f;
            const float pm0 = fmaxf(pe, g0), pm1 = fmaxf(pe, fmaxf(g0, g1));
            const float bl = __shfl(x, 63), gmax = __shfl(pm, 63);
            const float mnew = fmaxf(bl + mst, bl + gmax);
            bcs[2 * lane] = bc0; bcs[2 * lane + 1] = bc1; gs[2 * lane] = g0; gs[2 * lane + 1] = g1;
            ats[2 * lane] = fmaxf(pm0, mst); ats[2 * lane + 1] = fmaxf(pm1, mst);
            wss[2 * lane] = __expf(bl + g0 - mnew) * scale; wss[2 * lane + 1] = __expf(bl + g1 - mnew) * scale;
            if (lane == 0) { scal[0] = mnew; scal[1] = __expf(bl + mst - mnew); }
        }
        __syncthreads();
        const float mnew = scal[0], carry = scal[1];
        {
            const int row = prow_, cs = pcs_;
#pragma unroll
            for (int i = 0; i < 4; ++i) { const u32x4 q = pq[i]; *(LAS u32x4*)(Qs + row * 136 + cs * 32 + i * 8) = q; }
#pragma unroll
            for (int i = 0; i < 4; ++i) { const u32x4 k = pk[i]; *(LAS u32x4*)(KPs + row * 136 + cs * 32 + i * 8) = k;
                const int c0 = cs * 32 + i * 8;
                KTs[(c0 + 0) * 136 + row] = (bf16_t)(k.x & 0xffff); KTs[(c0 + 1) * 136 + row] = (bf16_t)(k.x >> 16);
                KTs[(c0 + 2) * 136 + row] = (bf16_t)(k.y & 0xffff); KTs[(c0 + 3) * 136 + row] = (bf16_t)(k.y >> 16);
                KTs[(c0 + 4) * 136 + row] = (bf16_t)(k.z & 0xffff); KTs[(c0 + 5) * 136 + row] = (bf16_t)(k.z >> 16);
                KTs[(c0 + 6) * 136 + row] = (bf16_t)(k.w & 0xffff); KTs[(c0 + 7) * 136 + row] = (bf16_t)(k.w >> 16); }
            const u32x4 v = pv; const float ws = wss[row];
            const unsigned vv[4] = {v.x, v.y, v.z, v.w};
#pragma unroll
            for (int e = 0; e < 4; ++e) { const int c0 = cs * 8 + 2 * e;
                VTs[c0 * 136 + row] = (bf16_t)(vv[e] & 0xffff); VTs[(c0 + 1) * 136 + row] = (bf16_t)(vv[e] >> 16);
                VWs[c0 * 136 + row] = (bf16_t)f2bf(bflo(vv[e]) * ws); VWs[(c0 + 1) * 136 + row] = (bf16_t)f2bf(bfhi(vv[e]) * ws); }
            if (tid < 128) VWs[32 * 136 + tid] = (bf16_t)f2bf(wss[tid]);
            if (p + 1 < 34) {
                if (tid < 128) { const int mr = b * T + tok_of(d, i0 + 128 + tid); pgi = Gt[(size_t)mr * 16 + d * 8 + head]; pgf = Gt[(size_t)mr * 16 + d * 8 + 4 + head]; }
                const bf16_t* sn_ = Pb + (size_t)(b * T + tok_of(d, i0 + 128 + prow_)) * PW + head * 128;
#pragma unroll
                for (int i = 0; i < 4; ++i) { pq[i] = *(const u32x4*)(sn_ + pcs_ * 32 + i * 8); pk[i] = *(const u32x4*)(sn_ + 1024 + pcs_ * 32 + i * 8); }
                pv = *(const u32x4*)(sn_ + 1536 + vq * 32 + pcs_ * 8);
            }
        }
        __syncthreads();
        f32x4 s[8];
#pragma unroll
        for (int i = 0; i < 8; ++i) s[i] = (f32x4){0.f, 0.f, 0.f, 0.f};
        mm16<8, 4>(Qs + wave * 16 * 136, 136, KPs, 136, s, fr, fq);
        __syncthreads();
        const int trow = wave * 16 + fr; const float at = ats[trow];
#pragma unroll
        for (int nt = 0; nt < 8; ++nt) { const f32x4 g4 = *(const LAS f32x4*)(gs + nt * 16 + fq * 4); float o[4];
#pragma unroll
            for (int e = 0; e < 4; ++e) { const int sc = nt * 16 + fq * 4 + e; const float w = __expf(fminf(g4[e] - at, 0.f)); o[e] = (sc <= trow) ? s[nt][e] * scale * w : 0.f; }
            u32x2 w2; w2.x = pk2(o[0], o[1]); w2.y = pk2(o[2], o[3]);
            *(LAS u32x2*)(KPs + trow * 136 + nt * 16 + fq * 4) = w2; }
        __syncthreads();
        f32x4 num[3], num2[3];
#pragma unroll
        for (int i = 0; i < 3; ++i) { num[i] = (f32x4){0.f, 0.f, 0.f, 0.f}; num2[i] = (f32x4){0.f, 0.f, 0.f, 0.f}; }
        mm16<3, 4>(KPs + wave * 16 * 136, 136, VTs, 136, num, fr, fq);
        mm16<3, 4>(Qs + wave * 16 * 136, 136, Cs, 136, num2, fr, fq);
        {
            const float rs = __shfl(num[2][0], fr), qn = __shfl(num2[2][0], fr);
            const float iw = __expf(mst - at), mt = bcs[trow] + at;
            const float den = fmaxf(fabsf(rs + iw * qn), __expf(-mt)); const float inv = 1.f / den;
            const int mrow = b * T + tok_of(d, i0 + trow);
#pragma unroll
            for (int nt = 0; nt < 2; ++nt) { const f32x4 o = (num[nt] + num2[nt] * iw) * inv;
                u32x2 w2; w2.x = pk2(o[0], o[1]); w2.y = pk2(o[2], o[3]);
                *(u32x2*)(HB + (size_t)mrow * 512 + head * 128 + vq * 32 + nt * 16 + fq * 4) = w2; }
        }
#pragma unroll
        for (int i = 0; i < 3; ++i) Ct[i] *= carry;
        mm16<3, 4>(KTs + wave * 16 * 136, 136, VWs, 136, Ct, fr, fq);
        __syncthreads();
#pragma unroll
        for (int nt = 0; nt < 3; ++nt)
#pragma unroll
            for (int e = 0; e < 4; ++e) Cs[(nt * 16 + fq * 4 + e) * 136 + wave * 16 + fr] = (bf16_t)f2bf(Ct[nt][e]);
        mst = mnew;
    }
    __syncthreads();
}

DI void attn_load_head(const bf16_t* Pb, int coloff, int b, int t0, const float* g, bool rope, float scale, const float* tab, LAS bf16_t* dst) {
    const int tid = tid_opaque(), row = tid >> 2, q4 = tid & 3; const int t = t0 + row; const size_t mrow = (size_t)b * T + t;
    const bf16_t* src = Pb + mrow * PW + coloff;
    float y[4][4]; float ss = 0.f;
#pragma unroll
    for (int c = 0; c < 4; ++c) { const u32x2 u = *(const u32x2*)(src + c * 16 + q4 * 4); y[c][0] = bflo(u.x); y[c][1] = bfhi(u.x); y[c][2] = bflo(u.y); y[c][3] = bfhi(u.y);
#pragma unroll
        for (int e = 0; e < 4; ++e) ss += y[c][e] * y[c][e]; }
    ss = red4(ss); const float rstd = rsqrtf(ss * (1.f / 64.f) + 1e-6f);
#pragma unroll
    for (int c = 0; c < 4; ++c)
#pragma unroll
        for (int e = 0; e < 4; ++e) y[c][e] = y[c][e] * rstd * g[c * 16 + q4 * 4 + e];
    if (rope) { const int pos = t - LC, rp = pos >> 6, cp = pos & 63;
#pragma unroll
        for (int e = 0; e < 4; ++e) { const int i = q4 * 4 + e;
            { const float co = tab[rp * 16 + i], si = tab[1024 + rp * 16 + i]; const float x1 = y[0][e], x2 = y[1][e]; y[0][e] = x1 * co - x2 * si; y[1][e] = x1 * si + x2 * co; }
            { const float co = tab[cp * 16 + i], si = tab[1024 + cp * 16 + i]; const float x1 = y[2][e], x2 = y[3][e]; y[2][e] = x1 * co - x2 * si; y[3][e] = x1 * si + x2 * co; } } }
#pragma unroll
    for (int c = 0; c < 4; ++c) { u32x2 w; w.x = pk2(y[c][0] * scale, y[c][1] * scale); w.y = pk2(y[c][2] * scale, y[c][3] * scale);
        *(LAS u32x2*)(dst + row * 72 + c * 16 + q4 * 4) = w; }
}
DI void attn_tile(int j, int tile, LAS unsigned char* lds) {
    unsigned char* ws = WSP();
    const int tid = tid_opaque(), wave = __builtin_amdgcn_readfirstlane(tid >> 6), lane = tid & 63, fr = lane & 15, fq = lane >> 4;
    int b, kvh, qb; bool lat;
    if (tile < 512) { lat = true; b = tile >> 6; kvh = (tile >> 5) & 1; qb = tile & 31; } else { const int c = tile - 512; lat = false; b = c >> 2; kvh = (c >> 1) & 1; qb = c & 1; }
    LAS bf16_t* Qs = (LAS bf16_t*)lds; LAS bf16_t* Ks = Qs + 4 * 128 * 72; LAS bf16_t* VTs = Ks + 128 * 72; LAS bf16_t* Ps = VTs + 64 * 136;
    bf16_t* Pb = (bf16_t*)(ws + EV_P); const float* tab = (const float*)(ws + WS_TAB);
    const float* qg = IN(15) + j * 64; const float* kg = IN(16) + j * 64; const float* sinkp = IN(17) + j * 8 + kvh * 4;
    const int tq0 = lat ? LC + qb * 128 : qb * 128;
    __syncthreads();
    for (int g = 0; g < 4; ++g) attn_load_head(Pb, 512 + (kvh * 4 + g) * 64, b, tq0, qg, lat, 0.125f, tab, Qs + g * 128 * 72);
    f32x4 O[4][4]; float mr[4], lr[4];
#pragma unroll
    for (int g = 0; g < 4; ++g) { mr[g] = sinkp[g]; lr[g] = 1.f;
#pragma unroll
        for (int i = 0; i < 4; ++i) O[g][i] = (f32x4){0.f, 0.f, 0.f, 0.f}; }
    const int nkb = lat ? 5 : 2;
    for (int kb = 0; kb < nkb; ++kb) {
        int tk0; int mask = 0; bool krope = false;
        if (kb < 2) tk0 = kb * 128;
        else { const int kq = qb + (kb - 3); if (kq < 0 || kq > 31) continue; tk0 = LC + kq * 128; krope = true; mask = kb == 2 ? 1 : (kb == 4 ? 2 : 0); }
        __syncthreads();
        attn_load_head(Pb, 2560 + kvh * 64, b, tk0, kg, krope, 1.f, tab, Ks);
        { const int row = tid >> 2, q4 = tid & 3; const bf16_t* src = Pb + ((size_t)b * T + tk0 + row) * PW + 2688 + kvh * 64 + q4 * 16;
          const u32x4 v0 = *(const u32x4*)src, v1 = *(const u32x4*)(src + 8); const unsigned vv[8] = {v0.x, v0.y, v0.z, v0.w, v1.x, v1.y, v1.z, v1.w};
#pragma unroll
          for (int e = 0; e < 8; ++e) { VTs[(q4 * 16 + 2 * e) * 136 + row] = (bf16_t)(vv[e] & 0xffff); VTs[(q4 * 16 + 2 * e + 1) * 136 + row] = (bf16_t)(vv[e] >> 16); } }
        __syncthreads();
        const float sgnf = mask == 1 ? 1.f : (mask == 2 ? -1.f : 0.f);
        const float basef = (float)(fq * 4 - (wave * 16 + fr)) * sgnf;
#pragma unroll
        for (int g = 0; g < 4; ++g) {
            asm volatile("" ::: "memory");
            f32x4 s[8];
#pragma unroll
            for (int i = 0; i < 8; ++i) s[i] = (f32x4){0.f, 0.f, 0.f, 0.f};
            mm16<8, 2>(Qs + g * 128 * 72 + wave * 16 * 72, 72, Ks, 72, s, fr, fq);
            const int qi = wave * 16 + fr;
            float mx = -3.0e38f;
#pragma unroll
            for (int nt = 0; nt < 8; ++nt)
#pragma unroll
                for (int e = 0; e < 4; ++e) { const float tf = fmaf(sgnf, (float)(nt * 16 + e), basef);
                    s[nt][e] += fminf(tf, 0.f) * 1.0e30f; mx = fmaxf(mx, s[nt][e]); }
            mx = fmaxf(mx, __shfl_xor(mx, 16)); mx = fmaxf(mx, __shfl_xor(mx, 32));
            const float mn = fmaxf(mr[g], mx); const float alpha = __expf(mr[g] - mn);
            float rs = 0.f;
#pragma unroll
            for (int nt = 0; nt < 8; ++nt) { float o[4];
#pragma unroll
                for (int e = 0; e < 4; ++e) { o[e] = __expf(s[nt][e] - mn); rs += o[e]; }
                u32x2 w2; w2.x = pk2(o[0], o[1]); w2.y = pk2(o[2], o[3]);
                *(LAS u32x2*)(Ps + qi * 136 + nt * 16 + fq * 4) = w2; }
            rs += __shfl_xor(rs, 16); rs += __shfl_xor(rs, 32);
            lr[g] = lr[g] * alpha + rs; mr[g] = mn;
#pragma unroll
            for (int i = 0; i < 4; ++i) O[g][i] *= alpha;
            mm16<4, 4>(Ps + wave * 16 * 136, 136, VTs, 136, O[g], fr, fq);
        }
    }
    { const size_t mrow = (size_t)b * T + tq0 + wave * 16 + fr;
#pragma unroll
      for (int g = 0; g < 4; ++g) { const float inv = 1.f / lr[g];
#pragma unroll
          for (int nt = 0; nt < 4; ++nt) { const f32x4 o = O[g][nt] * inv; u32x2 w2; w2.x = pk2(o[0], o[1]); w2.y = pk2(o[2], o[3]);
              *(u32x2*)(Pb + mrow * PW + 512 + (kvh * 4 + g) * 64 + nt * 16 + fq * 4) = w2; } } }
    __syncthreads();
}

DI void phase_ml_combine(int j) {
    const int tid0 = tid_opaque(); const int lane = tid0 & 63, wave = tid0 >> 6; unsigned char* ws = WSP();
    bf16_t* Pb = (bf16_t*)(ws + EV_P); const bf16_t* H0 = (const bf16_t*)(ws + EV_HB); const bf16_t* H1 = H0 + (size_t)M * 512;
    const float* og = IN(14) + j * 512; const int nw = GDIM() * 8; const int col = lane * 8;
    float ogv[8];
#pragma unroll
    for (int e = 0; e < 8; ++e) ogv[e] = og[col + e];
    for (int m0 = BIDX() * 8 + wave; m0 < M; m0 += 2 * nw) {
        const int m1 = (m0 + nw < M) ? m0 + nw : m0; const bool has1 = m0 + nw < M;
        u32x4 a[2], c[2], o[2];
#pragma unroll
        for (int r = 0; r < 2; ++r) { const size_t m = r ? m1 : m0; a[r] = *(const u32x4*)(H0 + m * 512 + col); c[r] = *(const u32x4*)(H1 + m * 512 + col); o[r] = *(const u32x4*)(Pb + m * PW + 2048 + col); }
#pragma unroll
        for (int r = 0; r < 2; ++r) {
            if (r == 1 && !has1) break;
            const size_t m = r ? m1 : m0;
            const unsigned av[4] = {a[r].x, a[r].y, a[r].z, a[r].w}, cv[4] = {c[r].x, c[r].y, c[r].z, c[r].w}, ov[4] = {o[r].x, o[r].y, o[r].z, o[r].w};
            float s[8]; float ss = 0.f;
#pragma unroll
            for (int e = 0; e < 4; ++e) { s[2 * e] = bflo(av[e]) + bflo(cv[e]); s[2 * e + 1] = bfhi(av[e]) + bfhi(cv[e]); ss += s[2 * e] * s[2 * e] + s[2 * e + 1] * s[2 * e + 1]; }
            ss = red16(ss); const float rstd = rsqrtf(ss * (1.f / 128.f) + 1e-6f);
            unsigned w[4];
#pragma unroll
            for (int e = 0; e < 4; ++e) { const float y0 = s[2 * e] * rstd * ogv[2 * e] * sigmoidf_(bflo(ov[e])); const float y1 = s[2 * e + 1] * rstd * ogv[2 * e + 1] * sigmoidf_(bfhi(ov[e])); w[e] = pk2(y0, y1); }
            u32x4 wv; wv.x = w[0]; wv.y = w[1]; wv.z = w[2]; wv.w = w[3];
            *(u32x4*)(Pb + m * PW + col) = wv;
        }
    }
}

DI void phase_rw_mix(int layer, int j, int q, LAS unsigned char* lds) {
    const int tid = tid_opaque(), lane = tid & 63, wave = tid >> 6; unsigned char* ws = WSP(); float* outp = OUTP();
    LAS float* hs = (LAS float*)lds;
    const float* g = IN(6) + layer * D; const float* mu = IN(18) + (size_t)j * 12 * D;
    bf16_t* X = (bf16_t*)(ws + OD_XQ);
    for (int it = BIDX(); it < QROWS / 17; it += GDIM()) {
        const int lr0 = it * 17, m0 = q * QROWS + lr0; const int b = m0 / T, t0 = m0 - b * T;
        __syncthreads();
        for (int rr = wave; rr < 19; rr += 8) {
            const int t = t0 - 1 + rr;
            if (t < 0 || t >= T) {
#pragma unroll
                for (int jj = 0; jj < 4; ++jj) *(LAS f32x4*)(hs + rr * 1024 + 4 * lane + 256 * jj) = (f32x4){0.f, 0.f, 0.f, 0.f};
            } else {
                const int who = t < LC ? 8 : b; const float* sh = modp(ws, layer, who, 0); const float* sc = modp(ws, layer, who, 1);
                const float* z = zrow(ws, outp, b * T + t); f32x4 v[4]; float ss = 0.f;
#pragma unroll
                for (int jj = 0; jj < 4; ++jj) { v[jj] = *(const f32x4*)(z + 4 * lane + 256 * jj); ss += v[jj][0] * v[jj][0] + v[jj][1] * v[jj][1] + v[jj][2] * v[jj][2] + v[jj][3] * v[jj][3]; }
                const float rstd = rsqrtf(wave_sum(ss) * (1.f / D) + 1e-6f);
#pragma unroll
                for (int jj = 0; jj < 4; ++jj) { const int c = 4 * lane + 256 * jj;
                    const f32x4 gg = *(const f32x4*)(g + c), a1 = *(const f32x4*)(sc + c), a0 = *(const f32x4*)(sh + c);
                    f32x4 y = v[jj] * rstd * gg; y = y * (a1 + 1.f) + a0; *(LAS f32x4*)(hs + rr * 1024 + c) = y; }
            }
        }
        __syncthreads();
        const int c4 = tid & 255, rh = tid >> 8;
        f32x4 mu0[6], mu1[6];
#pragma unroll
        for (int i = 0; i < 6; ++i) { mu0[i] = *(const f32x4*)(mu + (size_t)(i * 2) * D + 4 * c4); mu1[i] = *(const f32x4*)(mu + (size_t)(i * 2 + 1) * D + 4 * c4); }
        for (int k = 0; k < 9; ++k) { const int r = rh + 2 * k; if (r >= 17) break;
            const int t = t0 + r;
            const f32x4 u = *(const LAS f32x4*)(hs + (r + 1) * 1024 + 4 * c4);
            f32x4 pv = *(const LAS f32x4*)(hs + r * 1024 + 4 * c4), nx = *(const LAS f32x4*)(hs + (r + 2) * 1024 + 4 * c4);
            if (t == 0 || t == LC) pv = (f32x4){0.f, 0.f, 0.f, 0.f};
            if (t == LC - 1 || t == T - 1) nx = (f32x4){0.f, 0.f, 0.f, 0.f};
            const f32x4 dp = pv - u, dn = nx - u;
#pragma unroll
            for (int i = 0; i < 6; ++i) { const f32x4 x = u + mu0[i] * dp + mu1[i] * dn; u32x2 w; w.x = pk2(x[0], x[1]); w.y = pk2(x[2], x[3]);
                *(u32x2*)(X + (size_t)i * QROWS * D + (size_t)(lr0 + r) * D + 4 * c4) = w; } }
    }
    __syncthreads();
}

DI void rwkv_scan_item(int j, int item, LAS unsigned char* lds) {
    unsigned char* ws = WSP();
    const int tid = tid_opaque(), wave = __builtin_amdgcn_readfirstlane(tid >> 6), lane = tid & 63, fr = lane & 15, fq = lane >> 4;
    const int b = item >> 5, head = (item >> 1) & 15, d = item & 1;
    LAS float* steps = (LAS float*)lds;
    LAS bf16_t* L1w = (LAS bf16_t*)(lds + 98304);
    LAS bf16_t* W2w = (LAS bf16_t*)(lds + 107008);
    LAS bf16_t* W2a = (LAS bf16_t*)(lds + 116224);
    LAS float* ybuf = (LAS float*)(lds + 125440);
    const bf16_t* R = (const bf16_t*)(ws + OD_RKV); const bf16_t* Kb = R + (size_t)M * D; const bf16_t* Vb = Kb + (size_t)M * D;
    const bf16_t* L1 = (const bf16_t*)(ws + OD_L1);
    bf16_t* Y = (bf16_t*)(ws + OD_Y) + (size_t)d * M * D; float* SB = (float*)(ws + OD_SB) + (size_t)d * M * 16;
    constexpr int NC = T / 32;
    __syncthreads();
    { const int n = tid >> 3, kc = tid & 7;
      const bf16_t* sw = (const bf16_t*)(ws + W_2W_T) + ((size_t)(j * 2 + d) * D + head * 64 + n) * 64 + kc * 8;
      const bf16_t* sa = (const bf16_t*)(ws + W_2A_T) + ((size_t)(j * 2 + d) * D + head * 64 + n) * 64 + kc * 8;
      *(LAS u32x4*)(W2w + n * 72 + kc * 8) = *(const u32x4*)sw; *(LAS u32x4*)(W2a + n * 72 + kc * 8) = *(const u32x4*)sa; }
    __syncthreads();
    const int rp = (tid >> 3) & 31, cg8 = tid & 7;
    f32x4 s0a = (f32x4){0.f, 0.f, 0.f, 0.f}, s0b = s0a, s1a = s0a, s1b = s0a;
    for (int c = -1; c <= NC; ++c) {
        if (wave < 4) {
            if (c >= 0 && c < NC) {
                const LAS float* sbuf = steps + (c & 1) * 12288; LAS float* yb = ybuf + (c & 1) * 2048;
#pragma unroll 4
                for (int t = 0; t < 32; ++t) {
                    const LAS float* st = sbuf + t * 384 + cg8 * 8;
                    const f32x4 w4a = *(const LAS f32x4*)(st), w4b = *(const LAS f32x4*)(st + 4), k4a = *(const LAS f32x4*)(st + 64), k4b = *(const LAS f32x4*)(st + 68),
                                a4a = *(const LAS f32x4*)(st + 128), a4b = *(const LAS f32x4*)(st + 132), b4a = *(const LAS f32x4*)(st + 192), b4b = *(const LAS f32x4*)(st + 196),
                                r4a = *(const LAS f32x4*)(st + 256), r4b = *(const LAS f32x4*)(st + 260);
                    const float v0 = sbuf[t * 384 + 320 + rp], v1 = sbuf[t * 384 + 320 + rp + 32];
                    f32x4 p0 = s0a * a4a + s0b * a4b, p1 = s1a * a4a + s1b * a4b;
                    const f32x2 qa0 = p0.xy + p0.zw, qa1 = p1.xy + p1.zw;
                    float sa0 = qa0.x + qa0.y, sa1 = qa1.x + qa1.y;
                    sa0 = red8(sa0); sa1 = red8(sa1);
                    s0a = s0a * w4a + b4a * sa0 + k4a * v0; s0b = s0b * w4b + b4b * sa0 + k4b * v0;
                    s1a = s1a * w4a + b4a * sa1 + k4a * v1; s1b = s1b * w4b + b4b * sa1 + k4b * v1;
                    p0 = s0a * r4a + s0b * r4b; p1 = s1a * r4a + s1b * r4b;
                    const f32x2 qy0 = p0.xy + p0.zw, qy1 = p1.xy + p1.zw;
                    float y0 = qy0.x + qy0.y, y1 = qy1.x + qy1.y;
                    y0 = red8(y0); y1 = red8(y1);
                    yb[t * 64 + rp] = y0; yb[t * 64 + rp + 32] = y1;
                }
            }
        } else if (wave < 6) {
            const int cn = c + 1;
            if (cn < NC) {
                const int pw = wave - 4, r0 = pw * 16, i0 = cn * 32;
                LAS float* sbuf = steps + (cn & 1) * 12288; LAS bf16_t* Lw = L1w + pw * 16 * 136;
                u32x4 l1v[4]; u32x2 kv[4], rv[4], vv[4];
#pragma unroll
                for (int i = 0; i < 4; ++i) { const int q = lane + 64 * i; const int row = q >> 4, cc = q & 15; const int sc = cc < 8 ? d * 64 + cc * 8 : 128 + d * 64 + (cc - 8) * 8;
                    const size_t mr = (size_t)b * T + tok_of(d, i0 + r0 + row);
                    l1v[i] = *(const u32x4*)(L1 + mr * 256 + sc); }
#pragma unroll
                for (int i = 0; i < 4; ++i) { const int row = i * 4 + fq; const size_t mr = (size_t)b * T + tok_of(d, i0 + r0 + row);
                    kv[i] = *(const u32x2*)(Kb + mr * D + head * 64 + fr * 4); rv[i] = *(const u32x2*)(R + mr * D + head * 64 + fr * 4); vv[i] = *(const u32x2*)(Vb + mr * D + head * 64 + fr * 4); }
#pragma unroll
                for (int i = 0; i < 4; ++i) { const int q = lane + 64 * i; *(LAS u32x4*)(Lw + (q >> 4) * 136 + (q & 15) * 8) = l1v[i]; }
                asm volatile("s_waitcnt lgkmcnt(0)" ::: "memory");
                const float* w0 = IN(20) + (size_t)(j * 2 + d) * D + head * 64; const float* a0 = IN(23) + (size_t)(j * 2 + d) * D + head * 64;
                { f32x4 acc[4];
#pragma unroll
                  for (int i = 0; i < 4; ++i) acc[i] = (f32x4){0.f, 0.f, 0.f, 0.f};
                  mm16<4, 2>(Lw, 136, W2w, 72, acc, fr, fq);
#pragma unroll
                  for (int nt = 0; nt < 4; ++nt) { const int ch = nt * 16 + fq * 4; f32x4 o;
#pragma unroll
                      for (int e = 0; e < 4; ++e) { const float wp = w0[ch + e] + acc[nt][e]; const float wl = -__logf(1.f + __expf(-wp)) - 0.5f; o[e] = __expf(-__expf(wl)); }
                      *(LAS f32x4*)(sbuf + (r0 + fr) * 384 + ch) = o; } }
                { f32x4 acc[4];
#pragma unroll
                  for (int i = 0; i < 4; ++i) acc[i] = (f32x4){0.f, 0.f, 0.f, 0.f};
                  mm16<4, 2>(Lw + 64, 136, W2a, 72, acc, fr, fq);
#pragma unroll
                  for (int nt = 0; nt < 4; ++nt) { const int ch = nt * 16 + fq * 4; f32x4 o;
#pragma unroll
                      for (int e = 0; e < 4; ++e) o[e] = sigmoidf_(a0[ch + e] + acc[nt][e]);
                      *(LAS f32x4*)(sbuf + (r0 + fr) * 384 + 128 + ch) = o; } }
                asm volatile("s_waitcnt lgkmcnt(0)" ::: "memory");
                const float* kkw = IN(28) + j * D + head * 64; const float* kaw = IN(29) + j * D + head * 64; const float* rkw = IN(30) + (j * 16 + head) * 64;
#pragma unroll
                for (int i = 0; i < 4; ++i) {
                    const int row = r0 + i * 4 + fq, ch = fr * 4; const size_t mr = (size_t)b * T + tok_of(d, i0 + row);
                    const u32x2 ku = kv[i], ru = rv[i], vu = vv[i];
                    const float kf[4] = {bflo(ku.x), bfhi(ku.x), bflo(ku.y), bfhi(ku.y)}, rf[4] = {bflo(ru.x), bfhi(ru.x), bflo(ru.y), bfhi(ru.y)}, vf[4] = {bflo(vu.x), bfhi(vu.x), bflo(vu.y), bfhi(vu.y)};
                    LAS float* st = sbuf + row * 384;
                    const f32x4 as = *(const LAS f32x4*)(st + 128 + ch);
                    float kk[4], kd[4]; float ss = 0.f, bon = 0.f;
#pragma unroll
                    for (int e = 0; e < 4; ++e) { kk[e] = kf[e] * kkw[ch + e]; ss += kk[e] * kk[e]; kd[e] = kf[e] * (1.f + (as[e] - 1.f) * kaw[ch + e]); bon += rf[e] * kd[e] * rkw[ch + e]; }
                    ss = red16(ss); bon = red16(bon);
                    const float rn = rsqrtf(fmaxf(ss, 1e-24f));
                    f32x4 okd, oa, ob, orr, ov;
#pragma unroll
                    for (int e = 0; e < 4; ++e) { const float kn = kk[e] * rn; okd[e] = kd[e]; oa[e] = -kn; ob[e] = kn * as[e]; orr[e] = rf[e]; ov[e] = vf[e]; }
                    *(LAS f32x4*)(st + 64 + ch) = okd; *(LAS f32x4*)(st + 128 + ch) = oa; *(LAS f32x4*)(st + 192 + ch) = ob; *(LAS f32x4*)(st + 256 + ch) = orr; *(LAS f32x4*)(st + 320 + ch) = ov;
                    if (fr == 0) SB[mr * 16 + head] = bon;
                }
            }
        } else {
            const int cp = c - 1;
            if (cp >= 0 && cp < NC) {
                const int r0 = (wave - 6) * 16; const LAS float* yb = ybuf + (cp & 1) * 2048;
#pragma unroll
                for (int i = 0; i < 4; ++i) { const int row = r0 + i * 4 + fq; const size_t mr = (size_t)b * T + tok_of(d, cp * 32 + row);
                    const f32x4 y4 = *(const LAS f32x4*)(yb + row * 64 + fr * 4); u32x2 w; w.x = pk2(y4[0], y4[1]); w.y = pk2(y4[2], y4[3]);
                    *(u32x2*)(Y + mr * D + head * 64 + fr * 4) = w; }
            }
        }
        __syncthreads();
    }
}

DI void rwkv_post_tile(int j, int item, LAS unsigned char* lds) {
    const int tile = item >> 2, ncq = item & 3;
    unsigned char* ws = WSP();
    const int tid = tid_opaque(), wave = __builtin_amdgcn_readfirstlane(tid >> 6), lane = tid & 63, fr = lane & 15, fq = lane >> 4;
    LAS bf16_t* As = (LAS bf16_t*)lds; LAS bf16_t* Bs = As + 128 * 200;
    const bf16_t* G1 = (const bf16_t*)(ws + OD_G1); const bf16_t* G2 = (const bf16_t*)(ws + W_G2_T) + (size_t)j * D * 192;
    const bf16_t* Y0 = (const bf16_t*)(ws + OD_Y); const bf16_t* Y1 = Y0 + (size_t)M * D;
    const bf16_t* Vb = (const bf16_t*)(ws + OD_RKV) + (size_t)2 * M * D; bf16_t* Yo = (bf16_t*)(ws + OD_RKV);
    const float* SB0 = (const float*)(ws + OD_SB); const float* SB1 = SB0 + (size_t)M * 16;
    const float* lng = IN(31) + j * D; const float* lnb = IN(32) + j * D;
    const int m0 = tile * 128;
    __syncthreads();
    for (int i = 0; i < 6; ++i) { const int idx = tid + 512 * i; const int row = idx / 24, ch = idx - row * 24;
        *(LAS u32x4*)(As + row * 200 + ch * 8) = *(const u32x4*)(G1 + (size_t)(m0 + row) * 256 + ch * 8); }
    const size_t m = (size_t)m0 + wave * 16 + fr;
    for (int nc = ncq * 2; nc < ncq * 2 + 2; ++nc) {
        __syncthreads();
        for (int i = 0; i < 6; ++i) { const int idx = tid + 512 * i; const int row = idx / 24, ch = idx - row * 24;
            *(LAS u32x4*)(Bs + row * 200 + ch * 8) = *(const u32x4*)(G2 + (size_t)(nc * 128 + row) * 192 + ch * 8); }
        __syncthreads();
        f32x4 acc[8];
#pragma unroll
        for (int i = 0; i < 8; ++i) acc[i] = (f32x4){0.f, 0.f, 0.f, 0.f};
        mm16<8, 6>(As + wave * 16 * 200, 200, Bs, 200, acc, fr, fq);
#pragma unroll
        for (int hh = 0; hh < 2; ++hh) {
            const int H = nc * 2 + hh; float y[4][4]; float sum = 0.f;
#pragma unroll
            for (int q = 0; q < 4; ++q) { const int c = nc * 128 + (hh * 4 + q) * 16 + fq * 4;
                const u32x2 a = *(const u32x2*)(Y0 + m * D + c), bq = *(const u32x2*)(Y1 + m * D + c);
                y[q][0] = bflo(a.x) + bflo(bq.x); y[q][1] = bfhi(a.x) + bfhi(bq.x); y[q][2] = bflo(a.y) + bflo(bq.y); y[q][3] = bfhi(a.y) + bfhi(bq.y);
                sum += y[q][0] + y[q][1] + y[q][2] + y[q][3]; }
            sum += __shfl_xor(sum, 16); sum += __shfl_xor(sum, 32);
            const float mean = sum * (1.f / 64.f); float vs = 0.f;
#pragma unroll
            for (int q = 0; q < 4; ++q)
#pragma unroll
                for (int e = 0; e < 4; ++e) { y[q][e] -= mean; vs += y[q][e] * y[q][e]; }
            vs += __shfl_xor(vs, 16); vs += __shfl_xor(vs, 32);
            const float rstd = rsqrtf(vs * (1.f / 64.f) + 64e-5f);
            const float sb = SB0[m * 16 + H] + SB1[m * 16 + H];
#pragma unroll
            for (int q = 0; q < 4; ++q) { const int c = nc * 128 + (hh * 4 + q) * 16 + fq * 4;
                const u32x2 vu = *(const u32x2*)(Vb + m * D + c); const float vf[4] = {bflo(vu.x), bfhi(vu.x), bflo(vu.y), bfhi(vu.y)};
                float o[4];
#pragma unroll
                for (int e = 0; e < 4; ++e) o[e] = (y[q][e] * rstd * lng[c + e] + lnb[c + e] + sb * vf[e]) * acc[hh * 4 + q][e];
                u32x2 w; w.x = pk2(o[0], o[1]); w.y = pk2(o[2], o[3]);
                *(u32x2*)(Yo + m * D + c) = w; }
        }
    }
    __syncthreads();
}


constexpr size_t WS_BAR = WS_TAB + 131072;
#define XB_TMO      128
#define XB_XCNT(j)  (256  + 64 * (j))
#define XB_XSUB(j)  (1280 + 64 * (j))
#define XB_XGEN(j)  (2304 + 64 * (j))
#define XB_TOP      3328
#define XB_TOPGEN   3392
#define XCD_BAR_WORDS 3456
#define XB_SPIN_CAP (1u << 20)
DI unsigned xb_ld(unsigned* p)              { return __hip_atomic_load(p, __ATOMIC_RELAXED, __HIP_MEMORY_SCOPE_AGENT); }
DI unsigned xb_add(unsigned* p, unsigned v) { return __hip_atomic_fetch_add(p, v, __ATOMIC_RELAXED, __HIP_MEMORY_SCOPE_AGENT); }
DI unsigned xb_xcc_id() { return (unsigned)__builtin_amdgcn_s_getreg((3 << 11) | 20) & 0xFu; }
#define XB_SPIN(cond, bar) do { unsigned _sp = 0; while (cond) { __builtin_amdgcn_s_sleep(1); \
    if ((++_sp & 255u) == 0u) { if (xb_ld(&(bar)[XB_TMO])) break; if (_sp > XB_SPIN_CAP) { atomicAdd(&(bar)[XB_TMO], 1u); break; } } } } while (0)
struct XcdBarrier { unsigned* bar; unsigned x; volatile LAS unsigned* st; };
DI XcdBarrier xcd_barrier_post(unsigned* bar, volatile LAS unsigned* st) {
    XcdBarrier b; b.bar = bar; b.x = xb_xcc_id(); b.st = st;
    if (threadIdx.x == 0) (void)xb_add(&bar[XB_XCNT(b.x)], 1u);
    return b;
}
DI void xcd_barrier_complete(unsigned* bar, unsigned x, unsigned& nloc, unsigned& nx) {
    const unsigned G = GDIM() * gridDim.y * gridDim.z;
    unsigned sum, cnt, mine, sp = 0u;
    for (;;) {
        sum = 0u; cnt = 0u; mine = 0u;
#pragma unroll
        for (unsigned j = 0; j < 16; ++j) { const unsigned c = xb_ld(&bar[XB_XCNT(j)]); sum += c; cnt += (c > 0u) ? 1u : 0u; mine = (j == x) ? c : mine; }
        if (sum == G) break;
        __builtin_amdgcn_s_sleep(1);
        if ((++sp & 255u) == 0u) { if (xb_ld(&bar[XB_TMO])) break; if (sp > XB_SPIN_CAP) { atomicAdd(&bar[XB_TMO], 1u); break; } }
    }
    nloc = mine > 0u ? mine : 1u; nx = cnt > 0u ? cnt : 1u;
}
DI void xcd_barrier(const XcdBarrier& b) {
    asm volatile("s_waitcnt vmcnt(0) lgkmcnt(0)" ::: "memory");
    __syncthreads();
    if (threadIdx.x == 0) {
        unsigned* bar = b.bar;
        __builtin_amdgcn_s_waitcnt(0);
        unsigned nloc = b.st[0], nx = b.st[1];
        if (nloc == 0u) { xcd_barrier_complete(bar, b.x, nloc, nx); b.st[0] = nloc; b.st[1] = nx; }
        const unsigned old = xb_add(&bar[XB_XSUB(b.x)], 1u);
        const unsigned gen = old / nloc;
        if (old + 1u == (gen + 1u) * nloc) {
            __builtin_amdgcn_fence(__ATOMIC_RELEASE, "agent");
            asm volatile("s_waitcnt vmcnt(0)" ::: "memory");
            const unsigned og = xb_add(&bar[XB_TOP], 1u);
            const unsigned tg = og / nx;
            if (og + 1u == (tg + 1u) * nx) xb_add(&bar[XB_TOPGEN], 1u);
            else XB_SPIN(xb_ld(&bar[XB_TOPGEN]) == tg, bar);
            __builtin_amdgcn_fence(__ATOMIC_ACQUIRE, "agent");
            xb_add(&bar[XB_XGEN(b.x)], 1u);
            asm volatile("s_waitcnt vmcnt(0)" ::: "memory");
        } else {
            XB_SPIN(xb_ld(&bar[XB_XGEN(b.x)]) == gen, bar);
            __builtin_amdgcn_fence(__ATOMIC_ACQUIRE, "agent");
            asm volatile("s_waitcnt vmcnt(0)" ::: "memory");
        }
    }
    __syncthreads();
}

DI void gsync(cg::grid_group& grid) {
    asm volatile("s_waitcnt vmcnt(0) lgkmcnt(0)" ::: "memory");
    grid.sync();
    asm volatile("" ::: "memory");
}
__global__ void __launch_bounds__(NTHREADS) fwd_megakernel(Params P) {
    extern __shared__ __attribute__((aligned(16))) unsigned char lds_raw[];
    LAS unsigned char* lds = (LAS unsigned char*)lds_raw;
    LAS unsigned char* ldsc = (LAS unsigned char*)16u;
    cg::grid_group grid = cg::this_grid();
    const int G = GDIM(), bid = BIDX();
    volatile LAS unsigned* xst = (volatile LAS unsigned*)(lds + 155136);
    if (threadIdx.x < 2) xst[threadIdx.x] = 0u;
    __syncthreads();
    const XcdBarrier xbar = xcd_barrier_post((unsigned*)(WSP() + WS_BAR), xst);

#pragma unroll 1
    for (int s = 0; s < 45; ++s) {
        int layer = 0, op = 0, q = 0;
        if (s > 0) { int r = s - 1;
            if (r < 8) layer = 0; else if (r < 22) { layer = 1; r -= 8; } else if (r < 30) { layer = 2; r -= 22; } else { layer = 3; r -= 30; }
            if ((layer & 1) == 0) op = r < 5 ? 1 + r : 11 + (r - 5);
            else { if (r < 8) { op = 6 + (r & 1); q = r >> 1; } else op = r < 11 ? 8 + (r - 8) : 11 + (r - 11); } }
        const int j = layer >> 1;
        const int bl = sgpr_opaque(bid), Gl = sgpr_opaque(G);
        LAS unsigned char* ldsl = lds; asm volatile("" : "+s"(ldsl));
        switch (op) {
        case 0: phase_setup(ldsl); break;
        case 1: phase_norm(layer, IN(6) + layer * D, 0, (bf16_t*)(WSP() + EV_H), layer == 0); break;
        case 2: { unsigned char* ws = WSP(); pg8::StaticOrder S; S.init(M / 256, 12, Gl, bl);
              ADense af{(const bf16_t*)(ws + EV_H), D};
              EpiEvenIn E{(bf16_t*)(ws + EV_P), (float*)(ws + EV_G), IN(11) + j * 2832};
              pg8::gemm_phase(ldsl, af, (const bf16_t*)(ws + W_IN_T) + (size_t)j * 3072 * D, D, D, S, E); } break;
        case 3: for (int it = bl; it < 256; it += Gl) mlstm_item(j, it, ldsc);
                for (int it = bl; it < 544; it += Gl) attn_tile(j, it, ldsc); break;
        case 4: phase_ml_combine(j); break;
        case 5: { unsigned char* ws = WSP(); pg8::StaticOrder S; S.init(M / 256, 4, Gl, bl);
              ADense af{(const bf16_t*)(ws + EV_P), PW};
              EpiResid E{ws, OUTP(), layer, 2, layer == 0 ? IN(2) : (const float*)(ws + WS_ZC), layer == 0 ? IN(0) : (const float*)OUTP()};
              pg8::gemm_phase(ldsl, af, (const bf16_t*)(ws + W_EVO_T) + (size_t)j * D * D, PW, D, S, E); } break;
        case 6: phase_rw_mix(layer, j, q, ldsc); break;
        case 7: { unsigned char* ws = WSP(); pg8::StaticOrder S; S.init(QROWS / 256, 15, Gl, bl);
              ARwkv af{(const bf16_t*)(ws + OD_XQ)};
              EpiRwkv E{(bf16_t*)(ws + OD_RKV), (bf16_t*)(ws + OD_L1), (bf16_t*)(ws + OD_G1), q * QROWS};
              pg8::gemm_phase(ldsl, af, (const bf16_t*)(ws + W_RKVL_T) + (size_t)j * 3840 * D, D, D, S, E); } break;
        case 8: for (int it = bl; it < 256; it += Gl) rwkv_scan_item(j, it, ldsc); break;
        case 9: for (int it = bl; it < (M / 128) * 4; it += Gl) { if (layer == 3 && ((it >> 2) % 34) < 2) continue; rwkv_post_tile(j, it, ldsc); } break;
        case 10: { unsigned char* ws = WSP(); pg8::StaticOrder S; S.init(M / 256, 4, Gl, bl, layer == 3);
              ADense af{(const bf16_t*)(ws + OD_RKV), D};
              EpiResid E{ws, OUTP(), layer, 2, (const float*)(ws + WS_ZC), (const float*)OUTP()};
              pg8::gemm_phase(ldsl, af, (const bf16_t*)(ws + W_RWO_T) + (size_t)j * D * D, D, D, S, E); } break;
        case 11: phase_norm(layer, IN(7) + layer * D, 3, (bf16_t*)(WSP() + ML_H), false); break;
        case 12: { unsigned char* ws = WSP(); pg8::StaticOrder S; S.init(M / 256, 16, Gl, bl, layer == 3);
              ADense af{(const bf16_t*)(ws + ML_H), D};
              EpiRelu2 E{(bf16_t*)(ws + ML_HID), FF};
              pg8::gemm_phase(ldsl, af, (const bf16_t*)(ws + W_M1_T) + (size_t)layer * FF * D, D, D, S, E); } break;
        default: { unsigned char* ws = WSP(); pg8::StaticOrder S; S.init(M / 256, 4, Gl, bl, layer == 3);
              ADense af{(const bf16_t*)(ws + ML_HID), FF};
              EpiResid E{ws, OUTP(), layer, 5, (const float*)(ws + WS_ZC), (const float*)OUTP()};
              pg8::gemm_phase(ldsl, af, (const bf16_t*)(ws + W_M2_T) + (size_t)layer * D * FF, FF, FF, S, E); } break;
        }
        if (s == 0) gsync(grid);
        else if (s < 44) xcd_barrier(xbar);
    }
}

extern "C" void kernel_launch(void* const* d_in, const int* in_sizes, int n_in, void* d_out, int out_size, void* d_ws, size_t ws_size, hipStream_t stream) {
    static int grid_blocks = 0;
    if (grid_blocks == 0) {
        if (n_in != 34 || ws_size < WS_NEED) { fprintf(stderr, "kernel_launch: unexpected n_in %d / ws_size %zu (need %zu)\n", n_in, ws_size, (size_t)WS_NEED); grid_blocks = -1; return; }
        int dev = 0, cus = 0, per_cu = 0;
        hipGetDevice(&dev);
        hipDeviceGetAttribute(&cus, hipDeviceAttributeMultiprocessorCount, dev);
        if (hipFuncSetAttribute((const void*)fwd_megakernel, hipFuncAttributeMaxDynamicSharedMemorySize, LDS_BYTES) != hipSuccess) fprintf(stderr, "kernel_launch: hipFuncSetAttribute failed\n");
        hipOccupancyMaxActiveBlocksPerMultiprocessor(&per_cu, (const void*)fwd_megakernel, NTHREADS, LDS_BYTES);
        (void)hipGetLastError();
        if (per_cu < 1) per_cu = 1;
        grid_blocks = cus * 1;
    }
    if (grid_blocks < 0) return;
    if (hipMemsetAsync((char*)d_ws + WS_BAR, 0, XCD_BAR_WORDS * 4, stream) != hipSuccess) { fprintf(stderr, "kernel_launch: hipMemsetAsync of the barrier words failed\n"); return; }
    Params p{};
    for (int i = 0; i < 34; ++i) p.in[i] = (const float*)d_in[i];
    p.out = (float*)d_out; p.ws = (unsigned char*)d_ws;
    void* args[] = {&p};
    hipError_t e = hipLaunchCooperativeKernel((const void*)fwd_megakernel, dim3(grid_blocks), dim3(NTHREADS), args, LDS_BYTES, stream);
    if (e != hipSuccess) fprintf(stderr, "cooperative launch failed: %s (grid %d)\n", hipGetErrorString(e), grid_blocks);
}
```
